# Optimizing an MI355X kernel written in HIP

```python
import jax, jax.numpy as jnp
from jax import lax
import numpy as np

D_MODEL = 1024
BATCH = 2
SEQ = 8192
DEPTH = 4
DEC_BATCH = 128
DEC_SEQ = 4
PAST_LEN = 8192
PAGE_SIZE = 128

N_MIXERS = 3
N_POOL_LAYERS = len(range(0, DEPTH, N_MIXERS))
N_SWA_LAYERS = len(range(1, DEPTH, N_MIXERS))
N_HG_LAYERS = len(range(2, DEPTH, N_MIXERS))
D_FF = 4 * D_MODEL
EPS = 1e-6

POOL_WINDOWS = (2, 4, 8, 16)
POOL_GROUPS = len(POOL_WINDOWS)
POOL_GW = D_MODEL // POOL_GROUPS
POOL_BUF = max(POOL_WINDOWS) - 1

HEAD_DIM = 64
N_HEADS = D_MODEL // HEAD_DIM
N_KV = 4
GQA = N_HEADS // N_KV
WINDOW = 128
SWA_ROWS = min(WINDOW, PAST_LEN)
ROT_DIM = HEAD_DIM // 4
ROPE_THETA = 500000.0

HG_EXPAND = 128
HG_HEADS = D_MODEL // HG_EXPAND
HG_K = HG_EXPAND
HG_V = D_MODEL // HG_HEADS
HG_CHUNK = 64

kernel_name = "hybrid_pool_swa_hgrn2_decode_step"

F32 = jnp.float32


def _rmsnorm(x, g):
    xf = x.astype(F32)
    y = xf * lax.rsqrt(jnp.mean(xf * xf, axis=-1, keepdims=True) + EPS) * g.astype(F32)
    return y.astype(x.dtype)


def _sqrelu_ffn(u, w_up, w_down):
    h = jax.nn.relu(u @ w_up)
    return (h * h) @ w_down


def _pool_mix(u, buf, pos0, w_grp, scale):
    N, L, _ = u.shape
    uf = u.astype(F32)
    if buf is None:
        ext = jnp.pad(uf, ((0, 0), (POOL_BUF, 0), (0, 0)))
    else:
        ext = jnp.concatenate([buf.astype(F32), uf], axis=1)
    cs = jnp.pad(jnp.cumsum(ext, axis=1), ((0, 0), (1, 0), (0, 0)))
    end = cs[:, POOL_BUF + 1:]
    pos = pos0 + jnp.arange(L)
    diffs = []
    for g, w in enumerate(POOL_WINDOWS):
        sl = slice(g * POOL_GW, (g + 1) * POOL_GW)
        start = cs[:, POOL_BUF + 1 - w:POOL_BUF + 1 - w + L, sl]
        cnt = jnp.minimum(pos + 1, w).astype(F32)[None, :, None]
        diffs.append((end[..., sl] - start) / cnt - uf[..., sl])
    d = jnp.stack(diffs, axis=2)
    out = jnp.einsum('nlgc,gcd->nlgd', d, w_grp.astype(F32)).reshape(N, L, D_MODEL)
    out = out * scale.astype(F32)
    return out.astype(u.dtype), ext[:, -POOL_BUF:].astype(u.dtype)


def _rope(x, pos):
    half = ROT_DIM // 2
    inv = ROPE_THETA ** (-jnp.arange(half, dtype=F32) * 2.0 / ROT_DIM)
    ang = pos.astype(F32)[:, None] * inv[None, :]
    cos = jnp.cos(ang)[None, :, None, :]
    sin = jnp.sin(ang)[None, :, None, :]
    xr = x[..., :ROT_DIM].astype(F32)
    x1, x2 = xr[..., :half], xr[..., half:]
    rot = jnp.concatenate([x1 * cos - x2 * sin, x1 * sin + x2 * cos], axis=-1)
    return jnp.concatenate([rot.astype(x.dtype), x[..., ROT_DIM:]], axis=-1)


def _sink_attend(q, k, v, mask, sinks):
    s = jnp.einsum('...qkgd,...skd->...kgqs', q.astype(F32), k.astype(F32)) * (HEAD_DIM ** -0.5)
    s = jnp.where(mask, s, -jnp.inf)
    sink = jnp.broadcast_to(sinks.astype(F32).reshape(N_KV, GQA, 1, 1), s.shape[:-1] + (1,))
    p = jax.nn.softmax(jnp.concatenate([s, sink], axis=-1), axis=-1)[..., :-1]
    return jnp.einsum('...kgqs,...skd->...qkgd', p, v.astype(F32))


def _qkv(u, pos, wq, wk, wv):
    N, L, _ = u.shape
    q = _rope((u @ wq).reshape(N, L, N_HEADS, HEAD_DIM), pos)
    k = _rope((u @ wk).reshape(N, L, N_KV, HEAD_DIM), pos)
    v = (u @ wv).reshape(N, L, N_KV, HEAD_DIM)
    return q, k, v


def _swa_prompt(u, wq, wk, wv, wo, sinks):
    N, L, _ = u.shape
    q, k, v = _qkv(u, jnp.arange(L), wq, wk, wv)
    nb = L // WINDOW
    qb = q.reshape(N, nb, WINDOW, N_KV, GQA, HEAD_DIM)
    kb = k.reshape(N, nb, WINDOW, N_KV, HEAD_DIM)
    vb = v.reshape(N, nb, WINDOW, N_KV, HEAD_DIM)
    pad = ((0, 0), (1, 0), (0, 0), (0, 0), (0, 0))
    kk = jnp.concatenate([jnp.pad(kb, pad)[:, :-1], kb], axis=2)
    vv = jnp.concatenate([jnp.pad(vb, pad)[:, :-1], vb], axis=2)
    blk = jnp.arange(nb)[:, None] * WINDOW
    qpos = blk + jnp.arange(WINDOW)[None, :]
    kpos = blk - WINDOW + jnp.arange(2 * WINDOW)[None, :]
    dist = qpos[:, :, None] - kpos[:, None, :]
    mask = (dist >= 0) & (dist <= WINDOW) & (kpos[:, None, :] >= 0)
    o = _sink_attend(qb, kk, vv, mask[None, :, None, None], sinks)
    y = o.reshape(N, L, D_MODEL).astype(u.dtype) @ wo
    rows = min(WINDOW, L)
    return y, k[:, -rows:], v[:, -rows:]


def _swa_sample(u, ck, cv, pos0, wq, wk, wv, wo, sinks):
    N, L, _ = u.shape
    pos = pos0 + jnp.arange(L)
    q, k, v = _qkv(u, pos, wq, wk, wv)
    kk = jnp.concatenate([ck.astype(k.dtype), k], axis=1)
    vv = jnp.concatenate([cv.astype(v.dtype), v], axis=1)
    kpos = jnp.concatenate([pos0 - SWA_ROWS + jnp.arange(SWA_ROWS), pos])
    dist = pos[:, None] - kpos[None, :]
    mask = (dist >= 0) & (dist <= WINDOW)
    o = _sink_attend(q.reshape(N, L, N_KV, GQA, HEAD_DIM), kk, vv, mask[None, None, None], sinks)
    y = o.reshape(N, L, D_MODEL).astype(u.dtype) @ wo
    return y, kk[:, -SWA_ROWS:], vv[:, -SWA_ROWS:]


def _hgrn_mix(u, S0, lb, wf, wi, wq, wg, wo, gnorm):
    N, L, _ = u.shape
    f = lb + (1.0 - lb) * jax.nn.sigmoid((u @ wf).astype(F32))
    logf = jnp.log(f)
    kin = 1.0 - f
    vin = (u @ wi).astype(F32)
    qin = jax.nn.silu((u @ wq).astype(F32))
    C = HG_CHUNK if L % HG_CHUNK == 0 else L
    nc = L // C

    def chunks(a, dim):
        return a.reshape(N, nc, C, HG_HEADS, dim).transpose(1, 0, 3, 2, 4)

    xs = (chunks(qin, HG_K), chunks(kin, HG_K), chunks(vin, HG_V), chunks(logf, HG_K))
    causal = jnp.tril(jnp.ones((C, C), dtype=bool))

    def step(S, blk):
        qc, kc, vc, gc = blk
        G = jnp.cumsum(gc, axis=2)
        o_inter = jnp.einsum('nhtk,nhkv->nhtv', qc * jnp.exp(G), S)
        diff = G[:, :, :, None, :] - G[:, :, None, :, :]
        decay = jnp.exp(jnp.where(causal[:, :, None], diff, -jnp.inf))
        A = jnp.einsum('nhtk,nhtsk,nhsk->nhts', qc, decay, kc)
        o_intra = jnp.einsum('nhts,nhsv->nhtv', A, vc)
        G_end = G[:, :, -1:, :]
        S_new = jnp.exp(G_end[:, :, 0, :, None]) * S + jnp.einsum('nhsk,nhsv->nhkv', kc * jnp.exp(G_end - G), vc)
        return S_new, o_intra + o_inter

    S_fin, o = lax.scan(step, S0.astype(F32), xs)
    o = o.transpose(1, 0, 3, 2, 4).reshape(N, L, HG_HEADS, HG_V)
    o = o * lax.rsqrt(jnp.mean(o * o, axis=-1, keepdims=True) + EPS) * gnorm.astype(F32)
    gate = jax.nn.silu((u @ wg).astype(F32))
    y = (o.reshape(N, L, D_MODEL) * gate).astype(u.dtype) @ wo
    return y, S_fin


def setup_inputs(seed: int = 0) -> dict:
    key = jax.random.key(seed)
    keys = list(jax.random.split(key, 32))

    def nrm(shape, scale):
        return jax.random.normal(keys.pop(), shape, F32) * scale

    NP, NS, NH = N_POOL_LAYERS, N_SWA_LAYERS, N_HG_LAYERS
    dinv = D_MODEL ** -0.5
    return {
        "x_prompt": nrm((BATCH, SEQ, D_MODEL), 1.0),
        "x_sample": nrm((DEC_BATCH, DEC_SEQ, D_MODEL), 1.0),
        "state_pool": nrm((NP, DEC_BATCH, POOL_BUF, D_MODEL), 1.0),
        "cache_swa_k": nrm((NS, DEC_BATCH, SWA_ROWS, N_KV, HEAD_DIM), 1.0),
        "cache_swa_v": nrm((NS, DEC_BATCH, SWA_ROWS, N_KV, HEAD_DIM), 1.0),
        "state_hgrn": nrm((NH, DEC_BATCH, HG_HEADS, HG_K, HG_V), 1.0),
        "norm_mix": 1.0 + nrm((DEPTH, D_MODEL), 0.05),
        "norm_ffn": 1.0 + nrm((DEPTH, D_MODEL), 0.05),
        "norm_final": 1.0 + nrm((D_MODEL,), 0.05),
        "pool_w": nrm((NP, POOL_GROUPS, POOL_GW, POOL_GW), POOL_GW ** -0.5),
        "pool_scale": 1.0 + nrm((NP, D_MODEL), 0.05),
        "swa_wq": nrm((NS, D_MODEL, N_HEADS * HEAD_DIM), dinv),
        "swa_wk": nrm((NS, D_MODEL, N_KV * HEAD_DIM), dinv),
        "swa_wv": nrm((NS, D_MODEL, N_KV * HEAD_DIM), dinv),
        "swa_wo": nrm((NS, N_HEADS * HEAD_DIM, D_MODEL), dinv),
        "swa_sinks": nrm((NS, N_HEADS), 0.5),
        "hg_lower_bounds": nrm((DEPTH, HG_HEADS * HG_K), 0.5),
        "hg_wf": nrm((NH, D_MODEL, HG_HEADS * HG_K), dinv),
        "hg_wi": nrm((NH, D_MODEL, HG_HEADS * HG_V), dinv),
        "hg_wq": nrm((NH, D_MODEL, HG_HEADS * HG_K), dinv),
        "hg_wg": nrm((NH, D_MODEL, D_MODEL), dinv),
        "hg_wo": nrm((NH, D_MODEL, D_MODEL), dinv),
        "hg_gnorm": 1.0 + nrm((NH, HG_HEADS, HG_V), 0.05),
        "ffn_up": nrm((DEPTH, D_MODEL, D_FF), dinv),
        "ffn_down": nrm((DEPTH, D_FF, D_MODEL), D_FF ** -0.5),
    }


def reference(x_prompt, x_sample, state_pool, cache_swa_k, cache_swa_v, state_hgrn,
              norm_mix, norm_ffn, norm_final, pool_w, pool_scale,
              swa_wq, swa_wk, swa_wv, swa_wo, swa_sinks,
              hg_lower_bounds, hg_wf, hg_wi, hg_wq, hg_wg, hg_wo, hg_gnorm,
              ffn_up, ffn_down):
    lb_all = jnp.cumsum(jax.nn.softmax(hg_lower_bounds.astype(F32), axis=0), axis=0)
    lb_all = lb_all - lb_all[0:1]

    hp, hs = x_prompt, x_sample
    pool_p, pool_s, k_p, k_s, v_p, v_s, S_p, S_s = [], [], [], [], [], [], [], []
    ip = isw = ihg = 0
    for layer in range(DEPTH):
        kind = layer % N_MIXERS
        up = _rmsnorm(hp, norm_mix[layer])
        us = _rmsnorm(hs, norm_mix[layer])
        if kind == 0:
            mp, bp = _pool_mix(up, None, 0, pool_w[ip], pool_scale[ip])
            ms, bs = _pool_mix(us, state_pool[ip], PAST_LEN, pool_w[ip], pool_scale[ip])
            pool_p.append(bp)
            pool_s.append(bs)
            ip += 1
        elif kind == 1:
            mp, kp, vp = _swa_prompt(up, swa_wq[isw], swa_wk[isw], swa_wv[isw], swa_wo[isw], swa_sinks[isw])
            ms, ks, vs = _swa_sample(us, cache_swa_k[isw], cache_swa_v[isw], PAST_LEN,
                                     swa_wq[isw], swa_wk[isw], swa_wv[isw], swa_wo[isw], swa_sinks[isw])
            k_p.append(kp)
            v_p.append(vp)
            k_s.append(ks)
            v_s.append(vs)
            isw += 1
        else:
            S0 = jnp.zeros((up.shape[0], HG_HEADS, HG_K, HG_V), F32)
            mp, Sp = _hgrn_mix(up, S0, lb_all[layer], hg_wf[ihg], hg_wi[ihg], hg_wq[ihg],
                               hg_wg[ihg], hg_wo[ihg], hg_gnorm[ihg])
            ms, Ss = _hgrn_mix(us, state_hgrn[ihg], lb_all[layer], hg_wf[ihg], hg_wi[ihg], hg_wq[ihg],
                               hg_wg[ihg], hg_wo[ihg], hg_gnorm[ihg])
            S_p.append(Sp)
            S_s.append(Ss)
            ihg += 1
        hp = hp + mp
        hs = hs + ms
        hp = hp + _sqrelu_ffn(_rmsnorm(hp, norm_ffn[layer]), ffn_up[layer], ffn_down[layer])
        hs = hs + _sqrelu_ffn(_rmsnorm(hs, norm_ffn[layer]), ffn_up[layer], ffn_down[layer])

    y_prompt = _rmsnorm(hp, norm_final)
    y_sample = _rmsnorm(hs, norm_final)
    return (y_prompt, y_sample,
            jnp.stack(pool_p), jnp.stack(pool_s),
            jnp.stack(k_p), jnp.stack(k_s),
            jnp.stack(v_p), jnp.stack(v_s),
            jnp.stack(S_p), jnp.stack(S_s))
```

```cpp
#include <hip/hip_runtime.h>
#include <hip/hip_cooperative_groups.h>
#include <cstdio>
#include <cstdint>
#include <cmath>
namespace cg = cooperative_groups;

#define LAS __attribute__((address_space(3)))
typedef unsigned short bf16_t;
typedef short bf16x8 __attribute__((ext_vector_type(8)));
typedef float f32x4 __attribute__((ext_vector_type(4)));
typedef float f32x2 __attribute__((ext_vector_type(2)));
typedef float f32x16 __attribute__((ext_vector_type(16)));
typedef unsigned u32x4 __attribute__((ext_vector_type(4)));
typedef unsigned u32x2 __attribute__((ext_vector_type(2)));

#define MFMA_SETTLE4(a) asm volatile("s_nop 15\n\ts_nop 7" : "+v"(a))
#define MFMA_SETTLE16(a) asm volatile("s_nop 15\n\ts_nop 15" : "+v"(a))
constexpr int DM = 1024, FF = 4096, MP = 16384, MS = 512, MT = MP + MS, SEQ = 8192;
constexpr float EPS = 1e-6f;

typedef __bf16 bf16x2_t __attribute__((ext_vector_type(2)));
__device__ __forceinline__ unsigned cvt_pk_bf16(float lo, float hi) { f32x2 v = {lo, hi}; bf16x2_t b = __builtin_convertvector(v, bf16x2_t); return __builtin_bit_cast(unsigned, b); }
__device__ __forceinline__ void store16_sc1(void* p, u32x4 v) { asm volatile("global_store_dwordx4 %0, %1, off sc1" :: "v"(p), "v"(v) : "memory"); }
__device__ __forceinline__ float bf2f(unsigned short u) { return __uint_as_float(((unsigned)u) << 16); }
__device__ __forceinline__ float bflo(unsigned w) { return __uint_as_float(w << 16); }
__device__ __forceinline__ float bfhi(unsigned w) { return __uint_as_float(w & 0xffff0000u); }
__device__ __forceinline__ unsigned short f2bf(float f) { return (unsigned short)(cvt_pk_bf16(f, 0.f) & 0xffffu); }
__device__ __forceinline__ float wave_sum(float v) {
#pragma unroll
    for (int o = 1; o < 64; o <<= 1) v += __shfl_xor(v, o);
    return v;
}
__device__ __forceinline__ float wave_max(float v) {
#pragma unroll
    for (int o = 1; o < 64; o <<= 1) v = fmaxf(v, __shfl_xor(v, o));
    return v;
}

namespace pg8 {
#define PG8_LAS __attribute__((address_space(3)))
constexpr int BM = 256, BK = 64, HALF = 128, HTB = HALF * BK * 2  , STAGE_BYTES = 8 * HTB, NXCD = 8, WGM = 8;

__host__ __device__ __forceinline__ int lds_byte(int r, int c) { const int st = (r >> 4) * 2 + (c >> 5), rr = r & 15, cc = c & 31, ob = rr * 64 + cc * 2; return st * 1024 + (ob ^ (((ob >> 9) & 1) << 5)); }
__host__ __device__ __forceinline__ void stage_rc(int b, int& R, int& C) { const int st = b / 1024, sb = b % 1024, swz = sb ^ (((sb >> 9) & 1) << 5); R = (st >> 1) * 16 + swz / 64; C = (st & 1) * 32 + (swz % 64) / 2; }
__host__ __device__ __forceinline__ int perm32(int rho) { const int n = rho >> 4, i = rho & 15; return 8 * (i >> 2) + 4 * n + (i & 3); }

struct Unit { int pm, pn, ks, nt; };
struct Gemm { const bf16_t* A; const bf16_t* Bt; int M, N, K, lda, ldb, acol; };

struct StaticOrder {
    int nM, nN, nwg, G, c;
    __host__ __device__ void init(int M, int N, int G_, int c_) { nM = M / BM; nN = N / BM; nwg = nM * nN; G = G_; c = c_; }
    __host__ __device__ bool next(int i, Unit& u) const {
        const long L = (long)i * G + c; if (L >= nwg) return false;
        int wgid = (int)L; { const int q = nwg / NXCD, r = nwg % NXCD, xcd = wgid % NXCD, off = wgid / NXCD; wgid = (xcd < r ? xcd * (q + 1) : r * (q + 1) + (xcd - r) * q) + off; }
        const int nig = WGM * nN, gid = wgid / nig, fm = gid * WGM, gsz = (nM - fm) < WGM ? (nM - fm) : WGM;
        u.pm = fm + ((wgid % nig) % gsz); u.pn = (wgid % nig) / gsz; u.ks = 0; u.nt = 0; return true;
    }
    __device__ __forceinline__ void a_ready(const Unit&) const {}
    __device__ __forceinline__ void done(const Unit&) const {}
};
constexpr int KSLICE = 256;
struct DownOrder {
    StaticOrder so; int G, c, S;
    __host__ __device__ bool next(int i, Unit& u) const {
        const int L = i * G + c;
        if (L < 256) { StaticOrder t = so; t.G = 256; t.c = L; return t.next(0, u); }
        const int q = L - 256; if (q >= 8 * S) return false;
        u.ks = q >> 3; u.pm = 64 + ((q >> 2) & 1); u.pn = q & 3; u.nt = KSLICE / BK; return true;
    }
    __device__ __forceinline__ void a_ready(const Unit&) const {}
    __device__ __forceinline__ void done(const Unit&) const {}
};
template <class Epi, class Sched, bool ALIGN_EPI = false, bool SP2 = false>
__device__ __forceinline__ void gemm_phase(PG8_LAS unsigned char* lds, const Gemm g, const Sched& S, const Epi& E) {
    int tid_l = threadIdx.x; asm volatile("" : "+v"(tid_l));
    const int tid = tid_l, wid = __builtin_amdgcn_readfirstlane(tid >> 6), lane = tid & 63, wr = wid >> 2, wc = wid & 3, fr = lane & 15, fq = lane >> 4;
    const int K = g.K; int nt = K / BK;
    unsigned voffA[2], voffB[2];
#pragma unroll
    for (int i = 0; i < 2; ++i) { int R, C; stage_rc(tid * 16 + i * 8192, R, C); const int Rb = Epi::PERM ? ((R & ~31) + perm32(R & 31)) : R;
        voffA[i] = (unsigned)(R * g.lda + C) * 2u; voffB[i] = (unsigned)(Rb * g.ldb + C) * 2u; }
    const size_t kstep = (size_t)(BK * 2);
    const size_t hstepA = (size_t)HALF * g.lda * 2, hstepB = (size_t)HALF * g.ldb * 2;
    const size_t tstepA = 2 * hstepA, tstepB = 2 * hstepB, acolb = (size_t)g.acol * 2;
    const unsigned ldsw = (unsigned)wid * 1024u;
    const int aoff = lds_byte(wr * 64 + fr, fq * 8), boff = lds_byte(wc * 32 + fr, fq * 8);
#define PG8_SA(b, h) (((b) * 2 + (h)) * HTB)
#define PG8_SB(b, h) ((4 + (b) * 2 + (h)) * HTB)
#define PG8_STAGE(bufoff, gbase, voff) do { _Pragma("unroll") for (int _i = 0; _i < 2; ++_i) \
        __builtin_amdgcn_global_load_lds((const unsigned*)((const char*)(gbase) + (voff)[_i]), (PG8_LAS unsigned*)(lds + (bufoff) + ldsw + _i * 8192), 16, 0, 0); } while (0)
#define PG8_LDA(dst, b, h) do { _Pragma("unroll") for (int m = 0; m < 4; ++m) _Pragma("unroll") for (int k = 0; k < 2; ++k) dst[m][k] = *(const PG8_LAS bf16x8*)(lds + PG8_SA(b, h) + aoff + m * 2048 + k * 1024); } while (0)
#define PG8_LDB(dst, b, h) do { _Pragma("unroll") for (int n = 0; n < 2; ++n) _Pragma("unroll") for (int k = 0; k < 2; ++k) dst[n][k] = *(const PG8_LAS bf16x8*)(lds + PG8_SB(b, h) + boff + n * 2048 + k * 1024); } while (0)
#define PG8_MMA(ai, bj, At, Bt) do { __builtin_amdgcn_s_setprio(1); _Pragma("unroll") for (int m = 0; m < 4; ++m) _Pragma("unroll") for (int n = 0; n < 2; ++n) _Pragma("unroll") for (int k = 0; k < 2; ++k) \
        acc[ai][bj][m][n] = __builtin_amdgcn_mfma_f32_16x16x32_bf16(Bt[n][k], At[m][k], acc[ai][bj][m][n], 0, 0, 0); __builtin_amdgcn_s_setprio(0); } while (0)
#define PG8_WAIT_V(n) asm volatile("s_waitcnt vmcnt(" #n ")" ::: "memory")
#define PG8_WAIT_L(n) asm volatile("s_waitcnt lgkmcnt(" #n ")" ::: "memory")
#define PG8_BAR __builtin_amdgcn_s_barrier()
#define PG8_SCHED __builtin_amdgcn_sched_barrier(0)
    Unit cur, nxt; int ui = 0;
    if (!S.next(0, cur)) return;
    f32x4 acc[2][2][4][2];
#pragma unroll
    for (int a = 0; a < 2; ++a)
#pragma unroll
        for (int b = 0; b < 2; ++b)
#pragma unroll
            for (int m = 0; m < 4; ++m)
#pragma unroll
                for (int n = 0; n < 2; ++n) acc[a][b][m][n] = (f32x4){0.f, 0.f, 0.f, 0.f};
    bf16x8 At[4][2], B0[2][2], B1[2][2];
    if (cur.nt) nt = cur.nt;
    const size_t ksb = (size_t)KSLICE * 2;
    const char* cA = (const char*)g.A + (size_t)cur.pm * tstepA + (size_t)cur.pn * acolb + (size_t)cur.ks * ksb; const char* cB = (const char*)g.Bt + (size_t)cur.pn * tstepB + (size_t)cur.ks * ksb;
    S.a_ready(cur);
    if constexpr (SP2) {
        PG8_STAGE(PG8_SB(0, 0), cB, voffB); PG8_STAGE(PG8_SB(0, 1), cB + hstepB, voffB); PG8_STAGE(PG8_SA(0, 0), cA, voffA); PG8_STAGE(PG8_SA(0, 1), cA + hstepA, voffA);
        if (wr == 1) PG8_BAR;
        PG8_WAIT_V(2); PG8_BAR;
        PG8_STAGE(PG8_SB(1, 0), cB + kstep, voffB); PG8_STAGE(PG8_SA(1, 0), cA + kstep, voffA); PG8_STAGE(PG8_SB(1, 1), cB + hstepB + kstep, voffB);
        PG8_WAIT_V(6); PG8_BAR;
    } else {
        PG8_STAGE(PG8_SB(0, 0), cB, voffB); PG8_STAGE(PG8_SA(0, 0), cA, voffA); PG8_STAGE(PG8_SB(0, 1), cB + hstepB, voffB); PG8_STAGE(PG8_SA(0, 1), cA + hstepA, voffA);
        if (wr == 1) PG8_BAR;
        PG8_WAIT_V(4); PG8_BAR;
        PG8_STAGE(PG8_SB(1, 0), cB + kstep, voffB); PG8_STAGE(PG8_SA(1, 0), cA + kstep, voffA); PG8_STAGE(PG8_SB(1, 1), cB + hstepB + kstep, voffB);
        PG8_WAIT_V(6); PG8_BAR;
    }
    for (;;) {
        const bool has_next = S.next(ui + 1, nxt);
        const char* nA = has_next ? (const char*)g.A + (size_t)nxt.pm * tstepA + (size_t)nxt.pn * acolb + (size_t)nxt.ks * ksb : cA; const char* nB = has_next ? (const char*)g.Bt + (size_t)nxt.pn * tstepB + (size_t)nxt.ks * ksb : cB;
        for (int t = 0; t < nt; t += 2) {
            const bool last = (t == nt - 2);
            const char* a1 = cA + (size_t)(t + 1) * kstep;
            const char* a2 = last ? nA : cA + (size_t)(t + 2) * kstep; const char* b2 = last ? nB : cB + (size_t)(t + 2) * kstep;
            const char* a3 = a2 + kstep; const char* b3 = b2 + kstep;
            if (last && has_next) S.a_ready(nxt);
            if constexpr (SP2) {
            PG8_LDB(B0, 0, 0); PG8_LDB(B1, 0, 1); PG8_SCHED; PG8_LDA(At, 0, 0); PG8_STAGE(PG8_SA(1, 1), a1 + hstepA, voffA);
            PG8_WAIT_V(8); PG8_WAIT_L(0); PG8_BAR; PG8_MMA(0, 0, At, B0); PG8_MMA(0, 1, At, B1); PG8_BAR; PG8_SCHED;
            PG8_LDA(At, 0, 1); PG8_STAGE(PG8_SB(0, 0), b2, voffB); PG8_STAGE(PG8_SB(0, 1), b2 + hstepB, voffB); PG8_STAGE(PG8_SA(0, 0), a2, voffA);
            PG8_WAIT_V(8); PG8_WAIT_L(0); PG8_BAR; PG8_MMA(1, 0, At, B0); PG8_MMA(1, 1, At, B1); PG8_BAR; PG8_SCHED;
            PG8_LDB(B0, 1, 0); PG8_LDB(B1, 1, 1); PG8_SCHED; PG8_LDA(At, 1, 0); PG8_STAGE(PG8_SA(0, 1), a2 + hstepA, voffA);
            PG8_WAIT_V(8); PG8_WAIT_L(0); PG8_BAR; PG8_MMA(0, 0, At, B0); PG8_MMA(0, 1, At, B1); PG8_BAR; PG8_SCHED;
            PG8_LDA(At, 1, 1); PG8_STAGE(PG8_SB(1, 0), b3, voffB); PG8_STAGE(PG8_SB(1, 1), b3 + hstepB, voffB); PG8_STAGE(PG8_SA(1, 0), a3, voffA);
            PG8_WAIT_V(8); PG8_WAIT_L(0); PG8_BAR; PG8_MMA(1, 0, At, B0); PG8_MMA(1, 1, At, B1); PG8_BAR; PG8_SCHED;
            } else {
            PG8_LDB(B0, 0, 0); PG8_SCHED; PG8_LDA(At, 0, 0); PG8_STAGE(PG8_SA(1, 1), a1 + hstepA, voffA);
            PG8_WAIT_L(8); PG8_BAR; PG8_WAIT_L(0); PG8_MMA(0, 0, At, B0); PG8_BAR; PG8_SCHED;
            PG8_LDB(B1, 0, 1); PG8_STAGE(PG8_SB(0, 0), b2, voffB);
            PG8_BAR; PG8_WAIT_L(0); PG8_MMA(0, 1, At, B1); PG8_BAR;
            PG8_LDA(At, 0, 1); PG8_STAGE(PG8_SA(0, 0), a2, voffA);
            PG8_BAR; PG8_WAIT_L(0); PG8_MMA(1, 0, At, B0); PG8_BAR; PG8_SCHED;
            PG8_STAGE(PG8_SB(0, 1), b2 + hstepB, voffB);
            PG8_WAIT_V(6); PG8_BAR; PG8_MMA(1, 1, At, B1); PG8_BAR;
            PG8_LDB(B0, 1, 0); PG8_SCHED; PG8_LDA(At, 1, 0); PG8_STAGE(PG8_SA(0, 1), a2 + hstepA, voffA);
            PG8_WAIT_L(8); PG8_BAR; PG8_WAIT_L(0); PG8_MMA(0, 0, At, B0); PG8_BAR; PG8_SCHED;
            PG8_LDB(B1, 1, 1); PG8_STAGE(PG8_SB(1, 0), b3, voffB);
            PG8_BAR; PG8_WAIT_L(0); PG8_MMA(0, 1, At, B1); PG8_BAR;
            PG8_LDA(At, 1, 1); PG8_STAGE(PG8_SA(1, 0), a3, voffA);
            PG8_BAR; PG8_WAIT_L(0); PG8_MMA(1, 0, At, B0); PG8_BAR; PG8_SCHED;
            PG8_STAGE(PG8_SB(1, 1), b3 + hstepB, voffB);
            PG8_WAIT_V(6); PG8_BAR; PG8_MMA(1, 1, At, B1); PG8_BAR;
            }
        }
        if constexpr (ALIGN_EPI) { if (wr == 0) PG8_BAR; }
        if constexpr (!Epi::AFTER_DRAIN) { E(acc, cur, wr, wc, fr, fq); S.done(cur); }
        if (!has_next) break;
#pragma unroll
        for (int a = 0; a < 2; ++a)
#pragma unroll
            for (int b = 0; b < 2; ++b)
#pragma unroll
                for (int m = 0; m < 4; ++m)
#pragma unroll
                    for (int n = 0; n < 2; ++n) acc[a][b][m][n] = (f32x4){0.f, 0.f, 0.f, 0.f};
        cur = nxt; cA = nA; cB = nB; ++ui; nt = cur.nt ? cur.nt : K / BK;
        if constexpr (ALIGN_EPI) { if (wr == 1) PG8_BAR; }
    }
    PG8_WAIT_V(0);
    if constexpr (!ALIGN_EPI) { if (wr == 0) PG8_BAR; }
    PG8_BAR;
    if constexpr (Epi::AFTER_DRAIN) { E.fused(acc, cur, wr, wc, fr, fq, lds, wid, lane); S.done(cur); }
#undef PG8_SA
#undef PG8_SB
#undef PG8_STAGE
#undef PG8_LDA
#undef PG8_LDB
#undef PG8_MMA
#undef PG8_WAIT_V
#undef PG8_WAIT_L
#undef PG8_BAR
#undef PG8_SCHED
}
}

using pg8::Unit;
constexpr size_t MiB = 1u << 20;
constexpr size_t WS_SSQ = 0;
constexpr size_t WS_LB = 1280 * 1024;
constexpr size_t WS_ROPE = 1536 * 1024;
constexpr size_t WS_DC = 2560 * 1024;
constexpr size_t WS_W = 4 * MiB;
constexpr size_t W_UP0 = WS_W, W_DN0 = W_UP0 + 8 * MiB, W_UP1 = W_DN0 + 8 * MiB, W_DN1 = W_UP1 + 8 * MiB;
constexpr size_t W_QKV = W_DN1 + 8 * MiB, W_SWO = W_QKV + 3 * MiB, W_POOL0 = W_SWO + 2 * MiB;
constexpr size_t WS_GATE = WS_W;
constexpr size_t W_HG = WS_W + 38 * MiB, W_HGO = W_HG + 8 * MiB, W_UP2 = W_HGO + 2 * MiB, W_DN2 = W_UP2 + 8 * MiB, W_UP3 = W_DN2 + 8 * MiB, W_DN3 = W_UP3 + 8 * MiB, W_POOL1 = W_DN3 + 8 * MiB;
constexpr size_t WS_HB = WS_W + 81 * MiB;
constexpr size_t WS_R = WS_HB + 33 * MiB;
constexpr size_t R_HID = WS_R;
constexpr size_t R_D = WS_R;
constexpr size_t R_Q = WS_R, R_K = WS_R + 33 * MiB, R_V = R_K + 9 * MiB, R_O = R_V + 9 * MiB;
constexpr size_t R_LG = WS_R, R_HV = R_LG + 66 * MiB, R_HQ = R_HV + 33 * MiB, R_DS = R_HQ + 33 * MiB;
constexpr size_t WS_END = R_DS + 64 * MiB;
static_assert(W_POOL0 + MiB / 2 <= W_HG && WS_GATE + 33 * MiB <= W_HG && W_POOL1 + MiB / 2 <= WS_HB, "weights map");

constexpr size_t O_Y = 0, O_POOLP = (size_t)MT * DM, O_POOLS = O_POOLP + 2 * 2 * 15 * 1024, O_KP = O_POOLS + (size_t)2 * 128 * 15 * 1024,
                 O_KS = O_KP + 2 * 128 * 256, O_VP = O_KS + (size_t)128 * 128 * 256, O_VS = O_VP + 2 * 128 * 256, O_HP = O_VS + (size_t)128 * 128 * 256, O_HS = O_HP + 2 * 8 * 128 * 128;

constexpr int LDS_BYTES = 147456;

__device__ __forceinline__ float row_rinv(const float* ssq, int row) {
    const f32x4* p = (const f32x4*)(ssq + (size_t)row * 16);
    const f32x4 a = p[0], b = p[1], c = p[2], d = p[3];
    const float s = ((a.x + a.y) + (a.z + a.w)) + ((b.x + b.y) + (b.z + b.w)) + ((c.x + c.y) + (c.z + c.w)) + ((d.x + d.y) + (d.z + d.w));
    return rsqrtf(s * (1.f / 1024.f) + EPS);
}

struct EpiResid {
    static constexpr bool PERM = false, AFTER_DRAIN = false;
    const float* src_p; const float* src_s; float* h; bf16_t* hb; float* ssq; const float* cscale;
    __device__ __forceinline__ void operator()(const f32x4 (&acc)[2][2][4][2], const Unit& u, int wr, int wc, int fr, int fq) const {
        const int col0 = u.pn * 256 + wc * 32 + 4 * fq;
        f32x4 cs[2][2];
#pragma unroll
        for (int bj = 0; bj < 2; ++bj)
#pragma unroll
            for (int n = 0; n < 2; ++n) cs[bj][n] = cscale ? *(const f32x4*)(cscale + col0 + bj * 128 + n * 16) : (f32x4){1.f, 1.f, 1.f, 1.f};
#pragma unroll
        for (int ai = 0; ai < 2; ++ai)
#pragma unroll
            for (int m = 0; m < 4; ++m) {
                const int row = u.pm * 256 + ai * 128 + wr * 64 + m * 16 + fr;
                const float* sp = (row < MP ? src_p + (size_t)row * DM : src_s + (size_t)(row - MP) * DM) + col0;
                float* hp = h + (size_t)row * DM + col0; bf16_t* bp = hb + (size_t)row * DM + col0;
                float s = 0.f;
#pragma unroll
                for (int bj = 0; bj < 2; ++bj)
#pragma unroll
                    for (int n = 0; n < 2; ++n) {
                        const int off = bj * 128 + n * 16;
                        const f32x4 o = *(const f32x4*)(sp + off) + acc[ai][bj][m][n] * cs[bj][n];
                        *(f32x4*)(hp + off) = o;
                        u32x2 w; w.x = cvt_pk_bf16(o.x, o.y); w.y = cvt_pk_bf16(o.z, o.w); *(u32x2*)(bp + off) = w;
                        s += (o.x * o.x + o.y * o.y) + (o.z * o.z + o.w * o.w);
                    }
                s += __shfl_xor(s, 16); s += __shfl_xor(s, 32);
                if (fq == 0) ssq[(size_t)row * 16 + u.pn * 4 + wc] = s;
            }
    }
};
struct EpiPartial {
    static constexpr bool PERM = false, AFTER_DRAIN = false;
    float* P;
    __device__ __forceinline__ void operator()(const f32x4 (&acc)[2][2][4][2], const Unit& u, int wr, int wc, int fr, int fq) const {
        float* tp = P + (size_t)((u.ks * 8 + (u.pm - 64) * 4 + u.pn)) * 65536 + wc * 32 + 4 * fq;
#pragma unroll
        for (int ai = 0; ai < 2; ++ai)
#pragma unroll
            for (int m = 0; m < 4; ++m) {
                float* rp = tp + (ai * 128 + wr * 64 + m * 16 + fr) * 256;
#pragma unroll
                for (int bj = 0; bj < 2; ++bj)
#pragma unroll
                    for (int n = 0; n < 2; ++n) *(f32x4*)(rp + bj * 128 + n * 16) = acc[ai][bj][m][n];
            }
    }
};
struct EpiDown {
    static constexpr bool PERM = false, AFTER_DRAIN = false;
    EpiResid R; EpiPartial A;
    __device__ __forceinline__ void operator()(const f32x4 (&acc)[2][2][4][2], const Unit& u, int wr, int wc, int fr, int fq) const {
        if (u.nt) A(acc, u, wr, wc, fr, fq); else R(acc, u, wr, wc, fr, fq);
    }
};
struct EpiFfnUp {
    static constexpr bool PERM = true, AFTER_DRAIN = false;
    bf16_t* hid; const float* ssq;
    __device__ __forceinline__ void operator()(const f32x4 (&acc)[2][2][4][2], const Unit& u, int wr, int wc, int fr, int fq) const {
        const int col0 = u.pn * 256 + wc * 32 + 8 * fq;
#pragma unroll
        for (int ai = 0; ai < 2; ++ai)
#pragma unroll
            for (int m = 0; m < 4; ++m) {
                const int row = u.pm * 256 + ai * 128 + wr * 64 + m * 16 + fr;
                const float r = row_rinv(ssq, row);
                bf16_t* rp = hid + (size_t)row * FF + col0;
#pragma unroll
                for (int bj = 0; bj < 2; ++bj) {
                    f32x4 v0 = acc[ai][bj][m][0] * r, v1 = acc[ai][bj][m][1] * r;
#pragma unroll
                    for (int e = 0; e < 4; ++e) { const float a = fmaxf(v0[e], 0.f), b = fmaxf(v1[e], 0.f); v0[e] = a * a; v1[e] = b * b; }
                    u32x4 w; w.x = cvt_pk_bf16(v0[0], v0[1]); w.y = cvt_pk_bf16(v0[2], v0[3]); w.z = cvt_pk_bf16(v1[0], v1[1]); w.w = cvt_pk_bf16(v1[2], v1[3]);
                    *(u32x4*)(rp + bj * 128) = w;
                }
            }
    }
};
struct EpiQKV {
    static constexpr bool PERM = true, AFTER_DRAIN = false;
    bf16_t* Q; bf16_t* K; bf16_t* V; const float* ssq; const float* rope; float* okp; float* oks; float* ovp; float* ovs;
    __device__ __forceinline__ void operator()(const f32x4 (&acc)[2][2][4][2], const Unit& u, int wr, int wc, int fr, int fq) const {
        const int cl0 = wc * 32 + 8 * fq;
        const bool dorope = (u.pn <= 4) && ((wc & 1) == 0);
#pragma unroll
        for (int ai = 0; ai < 2; ++ai)
#pragma unroll
            for (int m = 0; m < 4; ++m) {
                const int row = u.pm * 256 + ai * 128 + wr * 64 + m * 16 + fr;
                const float r = row_rinv(ssq, row);
                const int pos = row < MP ? (row & (SEQ - 1)) : SEQ + ((row - MP) & 3);
                f32x4 cs[4];
                if (dorope) {
#pragma unroll
                    for (int e = 0; e < 4; ++e) cs[e] = *(const f32x4*)(rope + (size_t)pos * 16 + 4 * e);
                }
#pragma unroll
                for (int bj = 0; bj < 2; ++bj) {
                    f32x4 v0 = acc[ai][bj][m][0] * r, v1 = acc[ai][bj][m][1] * r;
                    if (dorope) {
                        f32x4 p0, p1;
#pragma unroll
                        for (int e = 0; e < 4; ++e) { p0[e] = __shfl_xor(v0[e], 16); p1[e] = __shfl_xor(v1[e], 16); }
                        if (fq < 2) {
                            const float sg = fq == 0 ? -1.f : 1.f;
                            v0[0] = v0[0] * cs[0][0] + sg * p0[0] * cs[0][1]; v0[1] = v0[1] * cs[0][2] + sg * p0[1] * cs[0][3];
                            v0[2] = v0[2] * cs[1][0] + sg * p0[2] * cs[1][1]; v0[3] = v0[3] * cs[1][2] + sg * p0[3] * cs[1][3];
                            v1[0] = v1[0] * cs[2][0] + sg * p1[0] * cs[2][1]; v1[1] = v1[1] * cs[2][2] + sg * p1[1] * cs[2][3];
                            v1[2] = v1[2] * cs[3][0] + sg * p1[2] * cs[3][1]; v1[3] = v1[3] * cs[3][2] + sg * p1[3] * cs[3][3];
                        }
                    }
                    u32x4 w; w.x = cvt_pk_bf16(v0[0], v0[1]); w.y = cvt_pk_bf16(v0[2], v0[3]); w.z = cvt_pk_bf16(v1[0], v1[1]); w.w = cvt_pk_bf16(v1[2], v1[3]);
                    const int cl = cl0 + bj * 128;
                    if (u.pn < 4) *(u32x4*)(Q + (size_t)row * DM + u.pn * 256 + cl) = w;
                    else {
                        bf16_t* dst = (u.pn == 4 ? K : V) + (size_t)row * 256 + cl; *(u32x4*)dst = w;
                        float* o = nullptr;
                        if (row < MP) { const int t = row & (SEQ - 1); if (t >= SEQ - 128) o = (u.pn == 4 ? okp : ovp) + ((size_t)(row >> 13) * 128 + (t - (SEQ - 128))) * 256 + cl; }
                        else { const int n = (row - MP) >> 2, i = (row - MP) & 3; o = (u.pn == 4 ? oks : ovs) + ((size_t)n * 128 + 124 + i) * 256 + cl; }
                        if (o) { *(f32x4*)o = v0; *(f32x4*)(o + 4) = v1; }
                    }
                }
            }
    }
};
struct EpiHg {
    static constexpr bool PERM = true, AFTER_DRAIN = false;
    float* LG; bf16_t* HV; bf16_t* HQ; bf16_t* GATE; const float* ssq; const float* lb;
    __device__ __forceinline__ void operator()(const f32x4 (&acc)[2][2][4][2], const Unit& u, int wr, int wc, int fr, int fq) const {
        const int type = u.pn >> 2, c0 = (u.pn & 3) * 256 + wc * 32 + 8 * fq;
        f32x4 lbv[2][2];
        if (type == 0) {
#pragma unroll
            for (int bj = 0; bj < 2; ++bj) { lbv[bj][0] = *(const f32x4*)(lb + c0 + bj * 128); lbv[bj][1] = *(const f32x4*)(lb + c0 + bj * 128 + 4); }
        }
#pragma unroll
        for (int ai = 0; ai < 2; ++ai)
#pragma unroll
            for (int m = 0; m < 4; ++m) {
                const int row = u.pm * 256 + ai * 128 + wr * 64 + m * 16 + fr;
                const float r = row_rinv(ssq, row);
#pragma unroll
                for (int bj = 0; bj < 2; ++bj) {
                    f32x4 v0 = acc[ai][bj][m][0] * r, v1 = acc[ai][bj][m][1] * r;
                    const int c = c0 + bj * 128;
                    if (type == 0) {
#pragma unroll
                        for (int e = 0; e < 4; ++e) {
                            const float s0 = 1.f / (1.f + __expf(-v0[e])), s1 = 1.f / (1.f + __expf(-v1[e]));
                            v0[e] = __logf(lbv[bj][0][e] + (1.f - lbv[bj][0][e]) * s0); v1[e] = __logf(lbv[bj][1][e] + (1.f - lbv[bj][1][e]) * s1);
                        }
                        float* o = LG + (size_t)row * DM + c; *(f32x4*)o = v0; *(f32x4*)(o + 4) = v1;
                    } else {
                        if (type >= 2) {
#pragma unroll
                            for (int e = 0; e < 4; ++e) { v0[e] = v0[e] / (1.f + __expf(-v0[e])); v1[e] = v1[e] / (1.f + __expf(-v1[e])); }
                        }
                        u32x4 w; w.x = cvt_pk_bf16(v0[0], v0[1]); w.y = cvt_pk_bf16(v0[2], v0[3]); w.z = cvt_pk_bf16(v1[0], v1[1]); w.w = cvt_pk_bf16(v1[2], v1[3]);
                        bf16_t* dst = (type == 1 ? HV : type == 2 ? HQ : GATE) + (size_t)row * DM + c;
                        *(u32x4*)dst = w;
                    }
                }
            }
    }
};

__device__ __forceinline__ void transpose_item(const float* W, int K, int N, const float* gain, bf16_t* WT, int ldk, int row_off, LAS float* scr, int item, int lane) {
    const int nblk = N / 32, kb = item / nblk, nb = item % nblk, k0 = 64 * kb, n0 = 32 * nb;
    float v[32];
#pragma unroll
    for (int i = 0; i < 32; ++i) v[i] = W[(size_t)(k0 + 2 * i + (lane >> 5)) * N + n0 + (lane & 31)];
    if (gain) {
#pragma unroll
        for (int i = 0; i < 32; ++i) v[i] *= gain[k0 + 2 * i + (lane >> 5)];
    }
#pragma unroll
    for (int i = 0; i < 32; ++i) scr[(2 * i + (lane >> 5)) * 33 + (lane & 31)] = v[i];
    asm volatile("s_waitcnt lgkmcnt(0)" ::: "memory");
    const int c = lane & 7;
#pragma unroll
    for (int j = 0; j < 4; ++j) { const int n = (lane >> 3) + 8 * j; const LAS float* s = scr + (8 * c) * 33 + n;
        u32x4 o; o.x = cvt_pk_bf16(s[0 * 33], s[1 * 33]); o.y = cvt_pk_bf16(s[2 * 33], s[3 * 33]); o.z = cvt_pk_bf16(s[4 * 33], s[5 * 33]); o.w = cvt_pk_bf16(s[6 * 33], s[7 * 33]);
        *(u32x4*)(WT + (size_t)(row_off + n0 + n) * ldk + k0 + 8 * c) = o; }
    asm volatile("s_waitcnt lgkmcnt(0)" ::: "memory");
}

struct Args { const float* in[25]; float* out; unsigned char* ws; };

template <bool SAMPLE>
__device__ __forceinline__ void pool_unit(const float* src_p, const float* src_s, const float* gmix, const float* buf, bf16_t* dbuf, float* opool, int unit, LAS float* rl, int tid, int wave, int lane) {
    const int b = unit >> 7, t0 = (unit & 127) * 64;
    const int nr = SAMPLE ? 4 : 79;
    for (int rr = wave; rr < nr; rr += 8) {
        const int t = SAMPLE ? rr : t0 - 15 + rr;
        float r = 0.f;
        if (SAMPLE || t >= 0) {
            const f32x4* xr = (const f32x4*)(SAMPLE ? src_s + (size_t)(unit * 4 + rr) * DM : src_p + (size_t)(b * SEQ + t) * DM) + lane;
            float s = 0.f;
#pragma unroll
            for (int j = 0; j < 4; ++j) { const f32x4 v = xr[64 * j]; s += (v.x * v.x + v.y * v.y) + (v.z * v.z + v.w * v.w); }
            r = rsqrtf(wave_sum(s) * (1.f / 1024.f) + EPS);
        }
        if (lane == 0) rl[rr] = r;
    }
    __syncthreads();
    const int cq = tid & 255, half = tid >> 8;
    if (!SAMPLE || half == 0) {
        const int w = 2 << (cq >> 6);
        const f32x4 g4 = *(const f32x4*)(gmix + 4 * cq);
        f32x4 ring[16];
#pragma unroll
        for (int it = 0; it < (SAMPLE ? 19 : 47); ++it) {
            f32x4 uv; int t;
            if (SAMPLE) {
                t = it - 15;
                if (it < 15) uv = *(const f32x4*)(buf + ((size_t)unit * 15 + it) * DM + 4 * cq);
                else uv = *(const f32x4*)(src_s + (size_t)(unit * 4 + t) * DM + 4 * cq) * rl[t] * g4;
            } else {
                const int rr = 32 * half + it; t = t0 - 15 + rr;
                uv = (f32x4){0.f, 0.f, 0.f, 0.f};
                if (t >= 0) uv = *(const f32x4*)(src_p + (size_t)(b * SEQ + t) * DM + 4 * cq) * rl[rr] * g4;
            }
            ring[it & 15] = uv;
            if (it >= 15) {
                const f32x4 s2 = ring[it & 15] + ring[(it - 1) & 15];
                const f32x4 s4 = s2 + (ring[(it - 2) & 15] + ring[(it - 3) & 15]);
                const f32x4 s8 = s4 + ((ring[(it - 4) & 15] + ring[(it - 5) & 15]) + (ring[(it - 6) & 15] + ring[(it - 7) & 15]));
                const f32x4 s16 = s8 + (((ring[(it - 8) & 15] + ring[(it - 9) & 15]) + (ring[(it - 10) & 15] + ring[(it - 11) & 15])) + ((ring[(it - 12) & 15] + ring[(it - 13) & 15]) + (ring[(it - 14) & 15] + ring[(it - 15) & 15])));
                const f32x4 s = w == 2 ? s2 : w == 4 ? s4 : w == 8 ? s8 : s16;
                const int cnt = SAMPLE ? w : (t + 1 < w ? t + 1 : w);
                const f32x4 d = s * (1.f / (float)cnt) - uv;
                const size_t row = SAMPLE ? (size_t)MP + unit * 4 + t : (size_t)b * SEQ + t;
                u32x2 pk; pk.x = cvt_pk_bf16(d.x, d.y); pk.y = cvt_pk_bf16(d.z, d.w);
                *(u32x2*)(dbuf + row * DM + 4 * cq) = pk;
            }
            if (SAMPLE) { if (it >= 4) *(f32x4*)(opool + ((size_t)unit * 15 + (it - 4)) * DM + 4 * cq) = uv; }
            else { if (t >= SEQ - 15) *(f32x4*)(opool + ((size_t)b * 15 + (t - (SEQ - 15))) * DM + 4 * cq) = uv; }
        }
    }
    __syncthreads();
}

__device__ __forceinline__ int crow(int r, int hi) { return (r & 3) + 8 * (r >> 2) + 4 * hi; }
__device__ __forceinline__ f32x16 attn_scores(const bf16_t* K, size_t rowbase, int q0, int j, int kvh, const bf16x8 (&qf)[4], int r32, int hi) {
    int krow = q0 - 128 + 32 * j + r32; krow = krow < 0 ? 0 : krow;
    const bf16_t* kp = K + (rowbase + krow) * 256 + kvh * 64 + hi * 8;
    f32x16 p = {};
#pragma unroll
    for (int d0 = 0; d0 < 4; ++d0) { const bf16x8 a = *(const bf16x8*)(kp + d0 * 16); p = __builtin_amdgcn_mfma_f32_32x32x16_bf16(a, qf[d0], p, 0, 0, 0); }
    MFMA_SETTLE16(p);
    const int qp = q0 + r32;
#pragma unroll
    for (int r = 0; r < 16; ++r) {
        const int kpos = q0 - 128 + 32 * j + crow(r, hi);
        const bool ok = (kpos >= 0) && (kpos <= qp) && (kpos >= qp - 128);
        p[r] = ok ? p[r] * 0.125f : -INFINITY;
    }
    return p;
}
__device__ __forceinline__ void attn_prompt_unit(const bf16_t* Q, const bf16_t* K, const bf16_t* V, bf16_t* O, const float* sinks, int unit, int wave, int lane) {
    const int kvh = unit & 3, qblk = (unit >> 2) & 127, b = unit >> 9;
    const int h = kvh * 4 + (wave & 3), q0 = qblk * 64 + 32 * (wave >> 2);
    const size_t rowbase = (size_t)b * SEQ;
    const int r32 = lane & 31, hi = lane >> 5;
    bf16x8 qf[4];
#pragma unroll
    for (int d0 = 0; d0 < 4; ++d0) qf[d0] = *(const bf16x8*)(Q + (rowbase + q0 + r32) * DM + h * 64 + d0 * 16 + hi * 8);
    const float sink = sinks[h];
    float mx = sink, l = 1.f;
#pragma unroll 1
    for (int j = 0; j < 5; ++j) {
        const f32x16 p = attn_scores(K, rowbase, q0, j, kvh, qf, r32, hi);
        float tm = p[0];
#pragma unroll
        for (int r = 1; r < 16; ++r) tm = fmaxf(tm, p[r]);
        tm = fmaxf(tm, __shfl_xor(tm, 32));
        const float mn = fmaxf(mx, tm);
        float ts = 0.f;
#pragma unroll
        for (int r = 0; r < 16; ++r) ts += __expf(p[r] - mn);
        ts += __shfl_xor(ts, 32);
        l = l * __expf(mx - mn) + ts; mx = mn;
    }
    const float inv = 1.f / l;
    f32x16 o0 = {}, o1 = {};
#pragma unroll 1
    for (int j = 0; j < 5; ++j) {
        f32x16 p = attn_scores(K, rowbase, q0, j, kvh, qf, r32, hi);
#pragma unroll
        for (int r = 0; r < 16; ++r) p[r] = __expf(p[r] - mx) * inv;
#pragma unroll
        for (int st = 0; st < 2; ++st) {
            u32x4 pw;
            pw.x = cvt_pk_bf16(p[8 * st + 0], p[8 * st + 1]); pw.y = cvt_pk_bf16(p[8 * st + 2], p[8 * st + 3]);
            pw.z = cvt_pk_bf16(p[8 * st + 4], p[8 * st + 5]); pw.w = cvt_pk_bf16(p[8 * st + 6], p[8 * st + 7]);
            const bf16x8 pa = __builtin_bit_cast(bf16x8, pw);
            bf16x8 vb0, vb1;
#pragma unroll
            for (int jj = 0; jj < 8; ++jj) {
                int krow = q0 - 128 + 32 * j + crow(8 * st + jj, hi); krow = krow < 0 ? 0 : krow;
                const bf16_t* vp = V + (rowbase + krow) * 256 + kvh * 64 + r32;
                vb0[jj] = (short)vp[0]; vb1[jj] = (short)vp[32];
            }
            o0 = __builtin_amdgcn_mfma_f32_32x32x16_bf16(pa, vb0, o0, 0, 0, 0);
            o1 = __builtin_amdgcn_mfma_f32_32x32x16_bf16(pa, vb1, o1, 0, 0, 0);
        }
    }
    MFMA_SETTLE16(o0); MFMA_SETTLE16(o1);
#pragma unroll
    for (int r = 0; r < 16; ++r) {
        bf16_t* op = O + (rowbase + q0 + crow(r, hi)) * DM + h * 64 + r32;
        op[0] = f2bf(o0[r]); op[32] = f2bf(o1[r]);
    }
}
__device__ __forceinline__ void attn_sample_wave(int n, int h, const bf16_t* Q, const bf16_t* K, const bf16_t* V, const float* ck, const float* cv, bf16_t* O, const float* sinks, LAS float* wl, int lane) {
    const int kvh = h >> 2; const size_t row0 = (size_t)MP + 4 * n;
    LAS float* wq = wl; LAS float* wp = wl + 256;
#pragma unroll
    for (int i = 0; i < 4; ++i) wq[i * 64 + lane] = bf2f(Q[(row0 + i) * DM + h * 64 + lane]);
    asm volatile("s_waitcnt lgkmcnt(0)" ::: "memory"); __builtin_amdgcn_wave_barrier();
    float sc[3][4];
#pragma unroll
    for (int kk = 0; kk < 3; ++kk) {
        float a0 = 0.f, a1 = 0.f, a2 = 0.f, a3 = 0.f;
        if (kk < 2) {
            const f32x4* kp = (const f32x4*)(ck + (((size_t)n * 128 + lane + 64 * kk) * 4 + kvh) * 64);
#pragma unroll 8
            for (int d4 = 0; d4 < 16; ++d4) { const f32x4 kv = kp[d4];
                const f32x4 q0 = *(const LAS f32x4*)(wq + 4 * d4), q1 = *(const LAS f32x4*)(wq + 64 + 4 * d4), q2 = *(const LAS f32x4*)(wq + 128 + 4 * d4), q3 = *(const LAS f32x4*)(wq + 192 + 4 * d4);
                a0 += (kv.x * q0.x + kv.y * q0.y) + (kv.z * q0.z + kv.w * q0.w); a1 += (kv.x * q1.x + kv.y * q1.y) + (kv.z * q1.z + kv.w * q1.w);
                a2 += (kv.x * q2.x + kv.y * q2.y) + (kv.z * q2.z + kv.w * q2.w); a3 += (kv.x * q3.x + kv.y * q3.y) + (kv.z * q3.z + kv.w * q3.w); }
        } else if (lane < 4) {
            const bf16_t* kp = K + (row0 + lane) * 256 + kvh * 64;
#pragma unroll 2
            for (int d = 0; d < 64; ++d) { const float kv = bf2f(kp[d]); a0 += kv * wq[d]; a1 += kv * wq[64 + d]; a2 += kv * wq[128 + d]; a3 += kv * wq[192 + d]; }
        }
        const float a[4] = {a0, a1, a2, a3};
#pragma unroll
        for (int i = 0; i < 4; ++i) {
            bool ok;
            if (kk < 2) ok = (lane + 64 * kk) >= i; else ok = (lane < 4) && (lane <= i);
            sc[kk][i] = ok ? a[i] * 0.125f : -INFINITY;
        }
    }
    const float sink = sinks[h];
#pragma unroll
    for (int i = 0; i < 4; ++i) {
        float mx = fmaxf(fmaxf(sc[0][i], sc[1][i]), sc[2][i]); mx = fmaxf(wave_max(mx), sink);
        const float e0 = __expf(sc[0][i] - mx), e1 = __expf(sc[1][i] - mx), e2 = __expf(sc[2][i] - mx);
        const float sum = wave_sum(e0 + e1 + e2) + __expf(sink - mx), inv = 1.f / sum;
        wp[i * 132 + lane] = e0 * inv; wp[i * 132 + 64 + lane] = e1 * inv; if (lane < 4) wp[i * 132 + 128 + lane] = e2 * inv;
    }
    asm volatile("s_waitcnt lgkmcnt(0)" ::: "memory"); __builtin_amdgcn_wave_barrier();
    float o[4] = {0.f, 0.f, 0.f, 0.f};
#pragma unroll 16
    for (int j = 0; j < 128; ++j) { const float v = cv[(((size_t)n * 128 + j) * 4 + kvh) * 64 + lane];
#pragma unroll
        for (int i = 0; i < 4; ++i) o[i] += wp[i * 132 + j] * v; }
#pragma unroll
    for (int jj = 0; jj < 4; ++jj) { const float v = bf2f(V[(row0 + jj) * 256 + kvh * 64 + lane]);
#pragma unroll
        for (int i = 0; i < 4; ++i) o[i] += wp[i * 132 + 128 + jj] * v; }
#pragma unroll
    for (int i = 0; i < 4; ++i) O[(row0 + i) * DM + h * 64 + lane] = f2bf(o[i]);
    asm volatile("s_waitcnt lgkmcnt(0)" ::: "memory"); __builtin_amdgcn_wave_barrier();
}

__device__ __forceinline__ f32x4 mma16(const LAS unsigned char* X, int xs, const LAS unsigned char* Y, int ys, int ksteps, f32x4 acc, int fr, int fq) {
    for (int ks = 0; ks < ksteps; ++ks) {
        const bf16x8 xv = *(const LAS bf16x8*)(X + fr * xs + ks * 64 + fq * 16);
        const bf16x8 yv = *(const LAS bf16x8*)(Y + fr * ys + ks * 64 + fq * 16);
        acc = __builtin_amdgcn_mfma_f32_16x16x32_bf16(xv, yv, acc, 0, 0, 0);
    }
    return acc;
}
constexpr int S272 = 272, S144 = 144;
constexpr int L_ST = 0, L_Q0 = 34816, L_QI = 52224, L_KT = 69632, L_A = 113152, L_VT = 122368, L_TOT = 140800, L_SSQ = 142848;
__device__ __forceinline__ void load_vt(LAS unsigned char* lds, const bf16_t* HV, size_t rowt0, int h, int tid) {
    const int s = tid >> 3, vc = (tid & 7) * 16;
    const u32x4* src = (const u32x4*)(HV + (rowt0 + s) * DM + h * 128 + vc);
    const u32x4 a = src[0], b = src[1];
    LAS unsigned short* vt = (LAS unsigned short*)(lds + L_VT);
    const unsigned w[8] = {a.x, a.y, a.z, a.w, b.x, b.y, b.z, b.w};
#pragma unroll
    for (int e = 0; e < 8; ++e) { vt[(vc + 2 * e) * 72 + s] = (unsigned short)(w[e] & 0xffffu); vt[(vc + 2 * e + 1) * 72 + s] = (unsigned short)(w[e] >> 16); }
}
__device__ __forceinline__ void hg_h1_unit(LAS unsigned char* lds, const float* LG, const bf16_t* HV, bf16_t* DS, float* Dc, int unit, int tid, int wave, int lane) {
    const int n = unit >> 10, h = (unit >> 7) & 7, c = unit & 127;
    const size_t rowt0 = (size_t)n * SEQ + c * 64;
    const int k = tid & 127, tq = tid >> 7;
    LAS float* tot = (LAS float*)(lds + L_TOT);
    float lg[16], cs[16];
    float run = 0.f;
#pragma unroll
    for (int i = 0; i < 16; ++i) { lg[i] = LG[(rowt0 + 16 * tq + i) * DM + h * 128 + k]; run += lg[i]; cs[i] = run; }
    tot[tq * 128 + k] = run;
    load_vt(lds, HV, rowt0, h, tid);
    __syncthreads();
    float base = 0.f, gend = 0.f;
#pragma unroll
    for (int q = 0; q < 4; ++q) { const float t = tot[q * 128 + k]; if (q < tq) base += t; gend += t; }
    LAS unsigned short* kt = (LAS unsigned short*)(lds + L_KT);
#pragma unroll
    for (int i = 0; i < 16; ++i) { const float kk = 1.f - __expf(lg[i]); kt[k * 72 + 16 * tq + i] = f2bf(kk * __expf(gend - (base + cs[i]))); }
    if (tq == 0) Dc[(size_t)unit * 128 + k] = __expf(gend);
    __syncthreads();
    const int fr = lane & 15, fq = lane >> 4;
#pragma unroll
    for (int vy = 0; vy < 8; ++vy) {
        f32x4 acc = {0.f, 0.f, 0.f, 0.f};
        acc = mma16(lds + L_KT + (16 * wave) * S144, S144, lds + L_VT + (16 * vy) * S144, S144, 2, acc, fr, fq);
        MFMA_SETTLE4(acc);
        u32x2 w; w.x = cvt_pk_bf16(acc[0], acc[1]); w.y = cvt_pk_bf16(acc[2], acc[3]);
        __hip_atomic_store((unsigned long long*)(DS + (size_t)unit * 16384 + (16 * vy + fr) * 128 + 16 * wave + 4 * fq), ((unsigned long long)w.y << 32) | w.x, __ATOMIC_RELAXED, __HIP_MEMORY_SCOPE_AGENT);
    }
    __syncthreads();
}
__device__ __forceinline__ void hg_h3_unit(LAS unsigned char* lds, const float* LG, const bf16_t* HV, bf16_t* HQ, const bf16_t* GATE, const bf16_t* DS, const float* gnorm, int unit, int tid, int wave, int lane) {
    const int n = unit >> 10, h = (unit >> 7) & 7, c = unit & 127;
    const size_t rowt0 = (size_t)n * SEQ + c * 64;
    const int k = tid & 127, tq = tid >> 7;
    LAS float* tot = (LAS float*)(lds + L_TOT);
    float lg[16], cs[16], qv[16];
    float run = 0.f;
#pragma unroll
    for (int i = 0; i < 16; ++i) { const size_t off = (rowt0 + 16 * tq + i) * DM + h * 128 + k; lg[i] = LG[off]; qv[i] = bf2f(HQ[off]); run += lg[i]; cs[i] = run; }
    tot[tq * 128 + k] = run;
#pragma unroll
    for (int e = 0; e < 4; ++e) { const int idx = tid + 512 * e, v = idx >> 4, ch = idx & 15;
        *(LAS u32x4*)(lds + L_ST + v * S272 + ch * 16) = *(const u32x4*)(DS + (size_t)unit * 16384 + v * 128 + ch * 8); }
    load_vt(lds, HV, rowt0, h, tid);
    __syncthreads();
    float bs[4]; { float a = 0.f;
#pragma unroll
        for (int q = 0; q < 4; ++q) { bs[q] = a; a += tot[q * 128 + k]; } }
    const float base = tq == 0 ? bs[0] : tq == 1 ? bs[1] : tq == 2 ? bs[2] : bs[3];
    LAS unsigned short* q0p = (LAS unsigned short*)(lds + L_Q0); LAS unsigned short* qip = (LAS unsigned short*)(lds + L_QI); LAS unsigned short* ktp = (LAS unsigned short*)(lds + L_KT);
#pragma unroll
    for (int i = 0; i < 16; ++i) {
        const int t = 16 * tq + i; const float G = base + cs[i];
        q0p[t * 136 + k] = f2bf(qv[i] * __expf(G));
        qip[t * 136 + k] = f2bf(qv[i] * __expf(cs[i]));
        const float kk = 1.f - __expf(lg[i]);
#pragma unroll
        for (int ii = 0; ii < 4; ++ii) if (ii >= tq) { const int rb = ii == 0 ? 0 : ii == 1 ? 16 : ii == 2 ? 48 : 96; ktp[(rb + t) * 136 + k] = f2bf(kk * __expf(bs[ii] - G)); }
    }
    __syncthreads();
    const int fr = lane & 15, fq = lane >> 4;
    for (int tl = wave; tl < 16; tl += 8) {
        int ti, tj;
        if (tl < 10) { ti = tl < 1 ? 0 : tl < 3 ? 1 : tl < 6 ? 2 : 3; tj = tl - (ti * (ti + 1)) / 2; }
        else { const int z = tl - 10; ti = z < 3 ? 0 : z < 5 ? 1 : 2; tj = z < 3 ? z + 1 : z < 5 ? z - 1 : 3; }
        f32x4 acc = {0.f, 0.f, 0.f, 0.f};
        if (tl < 10) {
            const int rb = ti == 0 ? 0 : ti == 1 ? 16 : ti == 2 ? 48 : 96;
            acc = mma16(lds + L_KT + (rb + 16 * tj) * S272, S272, lds + L_QI + (16 * ti) * S272, S272, 4, acc, fr, fq);
            MFMA_SETTLE4(acc);
            if (ti == tj) {
#pragma unroll
                for (int e = 0; e < 4; ++e) if (4 * fq + e > fr) acc[e] = 0.f;
            }
        }
        u32x2 w; w.x = cvt_pk_bf16(acc[0], acc[1]); w.y = cvt_pk_bf16(acc[2], acc[3]);
        *(LAS u32x2*)(lds + L_A + (16 * ti + fr) * S144 + (16 * tj + 4 * fq) * 2) = w;
    }
    const int tt = wave & 3, vh = wave >> 2;
    f32x4 oa[4];
#pragma unroll
    for (int vt = 0; vt < 4; ++vt) { oa[vt] = (f32x4){0.f, 0.f, 0.f, 0.f}; oa[vt] = mma16(lds + L_ST + (16 * (4 * vh + vt)) * S272, S272, lds + L_Q0 + (16 * tt) * S272, S272, 4, oa[vt], fr, fq); }
    __syncthreads();
    float ss = 0.f;
#pragma unroll
    for (int vt = 0; vt < 4; ++vt) oa[vt] = mma16(lds + L_VT + (16 * (4 * vh + vt)) * S144, S144, lds + L_A + (16 * tt) * S144, S144, 2, oa[vt], fr, fq);
    MFMA_SETTLE4(oa[0]); MFMA_SETTLE4(oa[1]); MFMA_SETTLE4(oa[2]); MFMA_SETTLE4(oa[3]);
#pragma unroll
    for (int vt = 0; vt < 4; ++vt) {
        ss += (oa[vt][0] * oa[vt][0] + oa[vt][1] * oa[vt][1]) + (oa[vt][2] * oa[vt][2] + oa[vt][3] * oa[vt][3]); }
    ss += __shfl_xor(ss, 16); ss += __shfl_xor(ss, 32);
    LAS float* sq = (LAS float*)(lds + L_SSQ);
    if (fq == 0) sq[vh * 64 + 16 * tt + fr] = ss;
    __syncthreads();
    const float rn = rsqrtf((sq[16 * tt + fr] + sq[64 + 16 * tt + fr]) * (1.f / 128.f) + EPS);
#pragma unroll
    for (int vt = 0; vt < 4; ++vt) {
        const int v = 16 * (4 * vh + vt) + 4 * fq; const size_t off = (rowt0 + 16 * tt + fr) * DM + h * 128 + v;
        const f32x4 gn = *(const f32x4*)(gnorm + h * 128 + v); const u32x2 gw = *(const u32x2*)(GATE + off);
        u32x2 w; w.x = cvt_pk_bf16(oa[vt][0] * rn * gn.x * bflo(gw.x), oa[vt][1] * rn * gn.y * bfhi(gw.x)); w.y = cvt_pk_bf16(oa[vt][2] * rn * gn.z * bflo(gw.y), oa[vt][3] * rn * gn.w * bfhi(gw.y));
        *(u32x2*)(HQ + off) = w;
    }
    __syncthreads();
}
__device__ __forceinline__ void hg_sample_unit(LAS unsigned char* lds, const float* S0, const float* LG, const bf16_t* HV, bf16_t* HQ, const bf16_t* GATE, const float* gnorm, float* Sout, int unit, int tid) {
    const int n = unit >> 3, h = unit & 7;
    const int v4 = (tid & 31) * 4, kg = tid >> 5;
    const size_t sbase = (size_t)unit * 16384;
    LAS float* red = (LAS float*)lds;
    LAS float* ol = (LAS float*)(lds + 32768);
    f32x4 S[8];
#pragma unroll
    for (int j = 0; j < 8; ++j) S[j] = *(const f32x4*)(S0 + sbase + (size_t)(8 * kg + j) * 128 + v4);
#pragma unroll 1
    for (int i = 0; i < 4; ++i) {
        const size_t roff = ((size_t)MP + 4 * n + i) * DM + h * 128;
        const u32x2 vw = *(const u32x2*)(HV + roff + v4);
        const f32x4 vv = {bflo(vw.x), bfhi(vw.x), bflo(vw.y), bfhi(vw.y)};
        f32x4 po = {0.f, 0.f, 0.f, 0.f};
#pragma unroll
        for (int j = 0; j < 8; ++j) {
            const float f = __expf(LG[roff + 8 * kg + j]), kk = 1.f - f, qq = bf2f(HQ[roff + 8 * kg + j]);
            S[j] = S[j] * f + vv * kk; po += S[j] * qq;
        }
        *(LAS f32x4*)(red + (i * 16 + kg) * 128 + v4) = po;
    }
#pragma unroll
    for (int j = 0; j < 8; ++j) *(f32x4*)(Sout + sbase + (size_t)(8 * kg + j) * 128 + v4) = S[j];
    __syncthreads();
    const int i = tid >> 7, v = tid & 127;
    float o = 0.f;
#pragma unroll
    for (int g = 0; g < 16; ++g) o += red[(i * 16 + g) * 128 + v];
    ol[i * 128 + v] = o;
    __syncthreads();
    float ss = 0.f;
    for (int e = 0; e < 128; e += 4) { const f32x4 x = *(const LAS f32x4*)(ol + i * 128 + e); ss += (x.x * x.x + x.y * x.y) + (x.z * x.z + x.w * x.w); }
    const float rn = rsqrtf(ss * (1.f / 128.f) + EPS);
    const size_t off = ((size_t)MP + 4 * n + i) * DM + h * 128 + v;
    HQ[off] = f2bf(o * rn * gnorm[h * 128 + v] * bf2f(GATE[off]));
    __syncthreads();
}


constexpr size_t WS_BAR = 1280 * 1024 + 8192;
#define XB_XCNT(j)  (256  + 64 * (j))
#define XB_XSUB(j)  (1280 + 64 * (j))
#define XB_XGEN(j)  (2304 + 64 * (j))
#define XB_TOP      3328
#define XB_TOPGEN   3392
constexpr int XB_BYTES = 16384;
struct GridBar { unsigned* bar; unsigned x, nloc, nx, G; };
__device__ __forceinline__ unsigned xb_ld(unsigned* p)              { return __hip_atomic_load(p, __ATOMIC_RELAXED, __HIP_MEMORY_SCOPE_AGENT); }
__device__ __forceinline__ unsigned xb_add(unsigned* p, unsigned v) { return __hip_atomic_fetch_add(p, v, __ATOMIC_RELAXED, __HIP_MEMORY_SCOPE_AGENT); }
__device__ __forceinline__ void grid_barrier_init(GridBar& b, unsigned* bar, unsigned G) {
    b.bar = bar; b.G = G; b.nloc = 0u; b.nx = 0u;
    b.x = (unsigned)__builtin_amdgcn_s_getreg((3 << 11) | 20) & 0xFu;
    if (threadIdx.x == 0) (void)xb_add(&bar[XB_XCNT(b.x)], 1u);
}
__device__ __forceinline__ void grid_barrier(GridBar& b) {
    asm volatile("s_waitcnt vmcnt(0)" ::: "memory");
    __syncthreads();
    if (threadIdx.x == 0) {
        unsigned* bar = b.bar;
        if (b.nloc == 0u) {
            for (;;) { unsigned sum = 0u, cnt = 0u, mine = 0u;
#pragma unroll
                for (unsigned j = 0; j < 16; ++j) { const unsigned c = xb_ld(&bar[XB_XCNT(j)]); sum += c; cnt += (c > 0u) ? 1u : 0u; mine = (j == b.x) ? c : mine; }
                if (sum == b.G) { b.nloc = mine; b.nx = cnt; break; }
                __builtin_amdgcn_s_sleep(1); }
        }
        const unsigned old = xb_add(&bar[XB_XSUB(b.x)], 1u), gen = old / b.nloc;
        if (old + 1u == (gen + 1u) * b.nloc) {
            __builtin_amdgcn_fence(__ATOMIC_RELEASE, "agent");
            asm volatile("s_waitcnt vmcnt(0)" ::: "memory");
            const unsigned og = xb_add(&bar[XB_TOP], 1u), tg = og / b.nx;
            if (og + 1u == (tg + 1u) * b.nx) (void)xb_add(&bar[XB_TOPGEN], 1u);
            else { while (xb_ld(&bar[XB_TOPGEN]) == tg) __builtin_amdgcn_s_sleep(1); }
            __builtin_amdgcn_fence(__ATOMIC_ACQUIRE, "agent");
            (void)xb_add(&bar[XB_XGEN(b.x)], 1u);
            asm volatile("s_waitcnt vmcnt(0)" ::: "memory");
        } else {
            while (xb_ld(&bar[XB_XGEN(b.x)]) == gen) __builtin_amdgcn_s_sleep(1);
            __builtin_amdgcn_fence(__ATOMIC_ACQUIRE, "agent");
            asm volatile("s_waitcnt vmcnt(0)" ::: "memory");
        }
    }
    __syncthreads();
}
#ifndef EN_POOL
#define EN_POOL 1
#define SKIP_SAMPLE 0
#ifndef USE_CG_SYNC
#define USE_CG_SYNC 0
#endif
#ifndef EXP_A
#define EXP_A 0
#endif
#ifndef SCAN_B
#define SCAN_B 16
#endif
#define NO_SCAN_STORE 0
#endif
#ifndef EN_ATT
#define EN_ATT 1
#endif
#ifndef EN_HG
#define EN_HG 1
#endif
#ifndef EN_GEMM
#define EN_GEMM 1
#endif
#ifndef EN_PRO
#define EN_PRO 1
#endif
#define IN(k) (LO <= (k) && (k) < HI)
#define PH_BEGIN const int tid = threadIdx.x; const int lane = tid & 63, wave = __builtin_amdgcn_readfirstlane(tid >> 6); (void)lane; (void)wave
#define SEAM(k) do { if (IN(k) && IN((k) + 1)) { grid_barrier(gbar); if (USE_CG_SYNC) grid.sync(); } } while (0)
#define GEMM_PHASE(EpiT, E, Aptr, Bptr, N_, K_, lda_, ldb_, acol_) do { if (!EN_GEMM) break; pg8::Gemm g{(const bf16_t*)(Aptr), (const bf16_t*)(Bptr), MT, (N_), (K_), (lda_), (ldb_), (acol_)}; \
        pg8::StaticOrder S; S.init(MT, (N_), G, bid); pg8::gemm_phase<EpiT, pg8::StaticOrder, true, true>(lds, g, S, E); } while (0)
#define RESID_SPLIT_GEMM(E_, APTR_, BPTR_, K_) \
            { \
                float* P = (float*)(ws + R_DS); \
                EpiDown ED{E_, EpiPartial{P}}; \
                pg8::Gemm g2{(const bf16_t*)(APTR_), (const bf16_t*)(BPTR_), MT, 1024, (K_), (K_), (K_), 0}; \
                pg8::DownOrder S2; S2.so.init(MP, 1024, 256, 0); S2.G = G; S2.c = bid; S2.S = (K_) / pg8::KSLICE; \
                if (EN_GEMM) pg8::gemm_phase<EpiDown, pg8::DownOrder, true, true>(lds, g2, S2, ED); \
                grid_barrier(gbar); \
                const int lane_ = threadIdx.x & 63, wave_ = __builtin_amdgcn_readfirstlane(threadIdx.x >> 6); \
                _Pragma("unroll 1") \
                for (int t = bid * 8 + wave_; t < MS * 4; t += G * 8) { \
                    const int r = t >> 2, qd = t & 3, row = MP + r; \
                    f32x4* xr = (f32x4*)(h + (size_t)row * DM) + qd * 64 + lane_; \
                    const float* pp = P + (size_t)((r >> 8) * 4 + qd) * 65536 + (r & 255) * 256 + 4 * lane_; \
                    f32x4 v = *xr; \
                _Pragma("unroll 8") \
                    for (int ks = 0; ks < (K_) / pg8::KSLICE; ++ks) v += *(const f32x4*)(pp + (size_t)(ks * 8) * 65536); \
                    *xr = v; \
                    u32x2 w; w.x = cvt_pk_bf16(v.x, v.y); w.y = cvt_pk_bf16(v.z, v.w); *((u32x2*)(hb + (size_t)row * DM) + qd * 64 + lane_) = w; \
                    const float sq = wave_sum((v.x * v.x + v.y * v.y) + (v.z * v.z + v.w * v.w)); \
                    if (lane_ == 0) ssq[(size_t)row * 16 + qd] = sq; \
                    else if (lane_ < 4) ssq[(size_t)row * 16 + 4 + qd * 3 + (lane_ - 1)] = 0.f; \
                } \
            }
template <int LO, int HI, int LAYER>
__device__ __forceinline__ void layer_phases(const Args& args, cg::grid_group& grid, GridBar& gbar, LAS unsigned char* lds, int G, int bid) {
    unsigned char* ws = args.ws; float* out = args.out;
    float* ssq = (float*)(ws + WS_SSQ); float* lbuf = (float*)(ws + WS_LB); float* rope = (float*)(ws + WS_ROPE); float* Dc = (float*)(ws + WS_DC);
    bf16_t* hb = (bf16_t*)(ws + WS_HB); float* h = out + O_Y;
    const float* xp = args.in[0]; const float* xs = args.in[1];
    const float* norm_mix = args.in[6];
        constexpr int layer = LAYER; constexpr int pb = layer * 7 + 1;
        constexpr int kind = layer % 3;
        const float* src_p = layer == 0 ? xp : h; const float* src_s = layer == 0 ? xs : h + (size_t)MP * DM;
        if constexpr (kind == 0) {
            constexpr int ip = layer / 3;
            if (IN(pb) && EN_POOL) {
                PH_BEGIN;
                LAS float* rl = (LAS float*)lds;
                bf16_t* dbuf = (bf16_t*)(ws + R_D);
                for (int u = bid; u < 256 + 128; u += G) {
                    if (u < 256) pool_unit<false>(src_p, src_s, norm_mix + layer * DM, nullptr, dbuf, out + O_POOLP + (size_t)ip * 2 * 15 * 1024, u, rl, tid, wave, lane);
                    else pool_unit<true>(src_p, src_s, norm_mix + layer * DM, args.in[2] + (size_t)ip * 128 * 15 * 1024, dbuf, out + O_POOLS + (size_t)ip * 128 * 15 * 1024, u - 256, rl, tid, wave, lane);
                }
            }
            SEAM(pb);
            if (IN(pb + 1)) {
                EpiResid E{src_p, src_s, h, hb, ssq, args.in[10] + ip * DM};
                GEMM_PHASE(EpiResid, E, ws + R_D, ws + (ip == 0 ? W_POOL0 : W_POOL1), 1024, 256, 1024, 256, 256);
            }
            SEAM(pb + 1);
        } else if constexpr (kind == 1) {
            if (IN(pb)) {
                EpiQKV E{(bf16_t*)(ws + R_Q), (bf16_t*)(ws + R_K), (bf16_t*)(ws + R_V), ssq, rope, out + O_KP, out + O_KS, out + O_VP, out + O_VS};
                GEMM_PHASE(EpiQKV, E, hb, ws + W_QKV, 1536, 1024, 1024, 1024, 0);
            }
            SEAM(pb);
            if (IN(pb + 1) && EN_ATT) {
                PH_BEGIN;
                const bf16_t* Qb = (const bf16_t*)(ws + R_Q); const bf16_t* Kb = (const bf16_t*)(ws + R_K); const bf16_t* Vb = (const bf16_t*)(ws + R_V); bf16_t* Ob = (bf16_t*)(ws + R_O);
                for (int u = bid; u < 1024; u += G) attn_prompt_unit(Qb, Kb, Vb, Ob, args.in[15], u, wave, lane);
                for (int u = bid; u < 256; u += G) { const int wu = u * 8 + wave; attn_sample_wave(wu >> 4, wu & 15, Qb, Kb, Vb, args.in[3], args.in[4], Ob, args.in[15], (LAS float*)(lds + wave * 4096), lane); }
                const int gt = bid * 512 + tid, NT = G * 512;
                for (int e = gt; e < 128 * 124 * 64; e += NT) { const int n = e / (124 * 64), rem = e % (124 * 64);
                    const size_t so = (size_t)n * 128 * 256 + 4 * 256 + (size_t)rem * 4, dd = (size_t)n * 128 * 256 + (size_t)rem * 4;
                    *(f32x4*)(out + O_KS + dd) = *(const f32x4*)(args.in[3] + so); *(f32x4*)(out + O_VS + dd) = *(const f32x4*)(args.in[4] + so); }
            }
            SEAM(pb + 1);
        } else {
            if (IN(pb)) {
                EpiHg E{(float*)(ws + R_LG), (bf16_t*)(ws + R_HV), (bf16_t*)(ws + R_HQ), (bf16_t*)(ws + WS_GATE), ssq, lbuf};
                GEMM_PHASE(EpiHg, E, hb, ws + W_HG, 4096, 1024, 1024, 1024, 0);
            }
            SEAM(pb);
            if ((IN(pb + 1) || IN(pb + 2) || IN(pb + 3)) && EN_HG) {
                const float* LG = (const float*)(ws + R_LG); const bf16_t* HV = (const bf16_t*)(ws + R_HV); bf16_t* HQ = (bf16_t*)(ws + R_HQ); const bf16_t* GATE = (const bf16_t*)(ws + WS_GATE); bf16_t* DS = (bf16_t*)(ws + R_DS);
                if (IN(pb + 1)) { PH_BEGIN; for (int u = bid; u < 2048; u += G) hg_h1_unit(lds, LG, HV, DS, Dc, u, tid, wave, lane); }
                SEAM(pb + 1);
                if (IN(pb + 2)) {
                PH_BEGIN;
                for (int gidx = bid * 512 + tid; gidx < 16 * 8192; gidx += G * 512) {
                    const int chain = gidx >> 13, e = (gidx & 8191) * 2, k = e & 127, v = e >> 7;
                    float s0 = 0.f, s1 = 0.f;
                    unsigned* dsp = (unsigned*)(DS + (size_t)chain * 128 * 16384 + e); const float* dcp = Dc + (size_t)chain * 128 * 128 + k;
                    for (int c0 = 0; c0 < 128; c0 += SCAN_B) {
                        unsigned dw[SCAN_B]; f32x2 dv[SCAN_B];
#pragma unroll
                        for (int j = 0; j < SCAN_B; ++j) { dw[j] = dsp[(size_t)(c0 + j) * 8192]; dv[j] = *(const f32x2*)(dcp + (size_t)(c0 + j) * 128); }
                        asm volatile("s_waitcnt vmcnt(0)" ::: "memory");
#pragma unroll
                        for (int j = 0; j < SCAN_B; ++j) { if (!NO_SCAN_STORE) dsp[(size_t)(c0 + j) * 8192] = cvt_pk_bf16(s0, s1); s0 = dv[j].x * s0 + bflo(dw[j]); s1 = dv[j].y * s1 + bfhi(dw[j]); }
                    }
                    float* o = out + O_HP + (size_t)chain * 16384; o[(size_t)k * 128 + v] = s0; o[(size_t)(k + 1) * 128 + v] = s1;
                }
                if (!SKIP_SAMPLE) for (int u = bid; u < 1024; u += G) hg_sample_unit(lds, args.in[5], LG, HV, HQ, GATE, args.in[22], out + O_HS, u, tid);
                }
                SEAM(pb + 2);
                if (IN(pb + 3)) { PH_BEGIN; for (int u = bid; u < 2048; u += G) hg_h3_unit(lds, LG, HV, HQ, GATE, DS, args.in[22], u, tid, wave, lane); }
                SEAM(pb + 3);
            }
        }
        if constexpr (kind != 0) {
            constexpr int ps = kind == 1 ? pb + 2 : pb + 4;
            if (IN(ps)) {
                EpiResid E{src_p, src_s, h, hb, ssq, nullptr};
                if constexpr (kind == 1) GEMM_PHASE(EpiResid, E, ws + R_O, ws + W_SWO, 1024, 1024, 1024, 1024, 0);
                else { RESID_SPLIT_GEMM(E, ws + R_HQ, ws + W_HGO, 1024); }
            }
            SEAM(ps);
        }
        const size_t wup = layer == 0 ? W_UP0 : layer == 1 ? W_UP1 : layer == 2 ? W_UP2 : W_UP3, wdn = layer == 0 ? W_DN0 : layer == 1 ? W_DN1 : layer == 2 ? W_DN2 : W_DN3;
        if (IN(pb + 5)) {
            EpiFfnUp E{(bf16_t*)(ws + R_HID), ssq};
            GEMM_PHASE(EpiFfnUp, E, hb, ws + wup, 4096, 1024, 1024, 1024, 0);
        }
        SEAM(pb + 5);
        if (IN(pb + 6) && !(EXP_A && (HI - LO) > 1)) {
            EpiResid E{h, h + (size_t)MP * DM, h, hb, ssq, nullptr};
            RESID_SPLIT_GEMM(E, ws + R_HID, ws + wdn, 4096);
        }
        SEAM(pb + 6);
    }
template <int LO, int HI>
__global__ void __launch_bounds__(512, 2) mega_fwd(Args args) {
    extern __shared__ __attribute__((aligned(16))) unsigned char lds_raw[];
    LAS unsigned char* lds = (LAS unsigned char*)lds_raw;
    cg::grid_group grid = cg::this_grid();
    const int G = gridDim.x, bid = blockIdx.x;
    GridBar gbar; grid_barrier_init(gbar, (unsigned*)(args.ws + WS_BAR), (unsigned)gridDim.x);
    if (HI - LO > 1 && gridDim.y == 0x7fffu) grid.sync();
    unsigned char* ws = args.ws; float* out = args.out;
    float* ssq = (float*)(ws + WS_SSQ); float* lbuf = (float*)(ws + WS_LB); float* rope = (float*)(ws + WS_ROPE); float* Dc = (float*)(ws + WS_DC);
    bf16_t* hb = (bf16_t*)(ws + WS_HB); float* h = out + O_Y;
    const float* xp = args.in[0]; const float* xs = args.in[1];
    const float* norm_mix = args.in[6]; const float* norm_ffn = args.in[7];

    if (IN(0) && EN_PRO) {
        PH_BEGIN;
        LAS float* scr = (LAS float*)(lds + wave * 16384);
        const int gw = bid * 8 + wave, NGW = G * 8;
        for (int it = gw; it < 20480; it += NGW) {
            int r = it;
#define TI(cnt, W, K, N, gain, dst, ldk, roff) if (r < (cnt)) { transpose_item((W), (K), (N), (gain), (bf16_t*)(ws + (dst)), (ldk), (roff), scr, r, lane); continue; } r -= (cnt);
            TI(2048, args.in[23] + (size_t)0 * DM * FF, DM, FF, norm_ffn + 0 * DM, W_UP0, DM, 0)
            TI(2048, args.in[23] + (size_t)1 * DM * FF, DM, FF, norm_ffn + 1 * DM, W_UP1, DM, 0)
            TI(2048, args.in[23] + (size_t)2 * DM * FF, DM, FF, norm_ffn + 2 * DM, W_UP2, DM, 0)
            TI(2048, args.in[23] + (size_t)3 * DM * FF, DM, FF, norm_ffn + 3 * DM, W_UP3, DM, 0)
            TI(2048, args.in[24] + (size_t)0 * DM * FF, FF, DM, nullptr, W_DN0, FF, 0)
            TI(2048, args.in[24] + (size_t)1 * DM * FF, FF, DM, nullptr, W_DN1, FF, 0)
            TI(2048, args.in[24] + (size_t)2 * DM * FF, FF, DM, nullptr, W_DN2, FF, 0)
            TI(2048, args.in[24] + (size_t)3 * DM * FF, FF, DM, nullptr, W_DN3, FF, 0)
            TI(512, args.in[11], DM, 1024, norm_mix + 1 * DM, W_QKV, DM, 0)
            TI(128, args.in[12], DM, 256, norm_mix + 1 * DM, W_QKV, DM, 1024)
            TI(128, args.in[13], DM, 256, norm_mix + 1 * DM, W_QKV, DM, 1280)
            TI(512, args.in[14], DM, 1024, nullptr, W_SWO, DM, 0)
            TI(512, args.in[17], DM, 1024, norm_mix + 2 * DM, W_HG, DM, 0)
            TI(512, args.in[18], DM, 1024, norm_mix + 2 * DM, W_HG, DM, 1024)
            TI(512, args.in[19], DM, 1024, norm_mix + 2 * DM, W_HG, DM, 2048)
            TI(512, args.in[20], DM, 1024, norm_mix + 2 * DM, W_HG, DM, 3072)
            TI(512, args.in[21], DM, 1024, nullptr, W_HGO, DM, 0)
            { const int pi = r >> 5; r &= 31;
              transpose_item(args.in[9] + (size_t)pi * 65536, 256, 256, nullptr, (bf16_t*)(ws + (pi < 4 ? W_POOL0 : W_POOL1)), 256, (pi & 3) * 256, scr, r, lane); }
#undef TI
        }
        const int gt = bid * 512 + tid, NT = G * 512;
        for (int c = gt; c < 1024; c += NT) {
            const float* p = args.in[16] + c; const float a0 = p[0], a1 = p[1024], a2 = p[2048], a3 = p[3072];
            const float mx = fmaxf(fmaxf(a0, a1), fmaxf(a2, a3)); const float e0 = expf(a0 - mx), e1 = expf(a1 - mx), e2 = expf(a2 - mx), e3 = expf(a3 - mx);
            lbuf[c] = (e1 + e2) / (e0 + e1 + e2 + e3);
        }
        for (int e = gt; e < 8196 * 8; e += NT) {
            const int pos = e >> 3, j = e & 7; const float inv = powf(500000.0f, -(float)j * 0.125f); const float ang = (float)pos * inv;
            rope[(size_t)pos * 16 + 2 * j] = cosf(ang); rope[(size_t)pos * 16 + 2 * j + 1] = sinf(ang);
        }
    }
    if (IN(0) && IN(1)) __syncthreads();


    layer_phases<LO, HI, 0>(args, grid, gbar, lds, G, bid);
    layer_phases<LO, HI, 1>(args, grid, gbar, lds, G, bid);
    layer_phases<LO, HI, 2>(args, grid, gbar, lds, G, bid);
    layer_phases<LO, HI, 3>(args, grid, gbar, lds, G, bid);
    if (IN(29)) {
        PH_BEGIN;
        const float* gf = args.in[8];
        for (int row = bid * 8 + wave; row < MT; row += G * 8) {
            f32x4* xr = (f32x4*)(h + (size_t)row * DM) + lane; f32x4 v[4]; float s = 0.f;
#pragma unroll
            for (int j = 0; j < 4; ++j) { v[j] = xr[64 * j]; s += (v[j].x * v[j].x + v[j].y * v[j].y) + (v[j].z * v[j].z + v[j].w * v[j].w); }
            const float r = rsqrtf(wave_sum(s) * (1.f / 1024.f) + EPS);
#pragma unroll
            for (int j = 0; j < 4; ++j) xr[64 * j] = v[j] * r * *((const f32x4*)gf + lane + 64 * j);
        }
    }
#undef IN
#undef SEAM
#undef GEMM_PHASE
}

#define HI_LIMIT 30
#ifndef N_LAUNCH_MODE
#define MERGE_LO 0
#define MERGE_HI 22
#define PLAN(X) X(0, 30)
#define N_LAUNCH_MODE 3
#endif
template <int LO, int HI> static void launch_range(int grid, Args& a, hipStream_t stream) {
    void* kargs[] = {&a};
    hipError_t e = hipLaunchCooperativeKernel((const void*)mega_fwd<LO, HI>, dim3(grid), dim3(512), kargs, LDS_BYTES, stream);
    if (e != hipSuccess) fprintf(stderr, "cooperative launch <%d,%d> failed: %s (grid %d)\n", LO, HI, hipGetErrorString(e), grid);
}
template <int LO, int HI> static void prep_range() { (void)hipFuncSetAttribute((const void*)mega_fwd<LO, HI>, hipFuncAttributeMaxDynamicSharedMemorySize, LDS_BYTES); }
#define FOR_PHASES(X) X(0) X(1) X(2) X(6) X(7) X(8) X(9) X(10) X(13) X(14) X(15) X(16) X(17) X(18) X(19) X(20) X(21) X(22) X(23) X(27) X(28) X(29)
extern "C" void kernel_launch(void* const* d_in, const int* in_sizes, int n_in, void* d_out, int out_size, void* d_ws, size_t ws_size, hipStream_t stream) {
    static int grid = 0;
    if (grid == 0) {
        if (n_in != 25 || ws_size < WS_END) { fprintf(stderr, "kernel_launch: bad shapes: n_in %d ws %zu (need %zu)\n", n_in, ws_size, (size_t)WS_END); grid = -1; return; }
        int dev = 0, cus = 0, per_cu = 0;
        (void)hipGetDevice(&dev); (void)hipDeviceGetAttribute(&cus, hipDeviceAttributeMultiprocessorCount, dev);
#if N_LAUNCH_MODE == 1
        prep_range<0, 30>();
        (void)hipOccupancyMaxActiveBlocksPerMultiprocessor(&per_cu, (const void*)mega_fwd<0, 30>, 512, LDS_BYTES);
#elif N_LAUNCH_MODE == 3
#define PREP_R(a, b) prep_range<a, b>();
        PLAN(PREP_R)
        per_cu = 1;
#elif N_LAUNCH_MODE == 2
        prep_range<MERGE_LO, MERGE_HI>();
#define PREP(k) prep_range<k, k + 1>();
        FOR_PHASES(PREP)
        per_cu = 1;
#else
#define PREP(k) prep_range<k, k + 1>();
        FOR_PHASES(PREP)
        per_cu = 1;
#endif
        if (per_cu < 1) per_cu = 1;
        grid = cus * per_cu;
        (void)hipGetLastError();
    }
    if (grid < 0) return;
    (void)hipMemsetAsync((char*)d_ws + WS_BAR, 0, XB_BYTES, stream);
    Args a{};
    for (int i = 0; i < 25; ++i) a.in[i] = (const float*)d_in[i];
    a.out = (float*)d_out; a.ws = (unsigned char*)d_ws;
    Args& args_ = a; (void)args_;
#if N_LAUNCH_MODE == 1
    launch_range<0, 30>(grid, a, stream);
#elif N_LAUNCH_MODE == 3
#define LAUNCH_R(a, b) launch_range<a, b>(grid, args_, stream);
    PLAN(LAUNCH_R)
#elif N_LAUNCH_MODE == 2
#define LAUNCH_A(k) if ((k) < MERGE_LO) launch_range<k, k + 1>(grid, a, stream);
    FOR_PHASES(LAUNCH_A)
    launch_range<MERGE_LO, MERGE_HI>(grid, a, stream);
    if (EXP_A) launch_range<7, 8>(grid, a, stream);
#define LAUNCH_B(k) if ((k) >= MERGE_HI) launch_range<k, k + 1>(grid, a, stream);
    FOR_PHASES(LAUNCH_B)
#else
#ifndef HI_LIMIT
#define HI_LIMIT 30
#endif
#define LAUNCH(k) if ((k) < HI_LIMIT) launch_range<k, k + 1>(grid, a, stream);
    FOR_PHASES(LAUNCH)
#endif
}
```

```cpp
#include <hip/hip_runtime.h>
#include <hip/hip_cooperative_groups.h>
#include <cstdio>
#include <cstdint>
#include <cmath>
namespace cg = cooperative_groups;

#define LAS __attribute__((address_space(3)))
typedef unsigned short bf16_t;
typedef short bf16x8 __attribute__((ext_vector_type(8)));
typedef float f32x4 __attribute__((ext_vector_type(4)));
typedef float f32x2 __attribute__((ext_vector_type(2)));
typedef float f32x16 __attribute__((ext_vector_type(16)));
typedef unsigned u32x4 __attribute__((ext_vector_type(4)));
typedef unsigned u32x2 __attribute__((ext_vector_type(2)));

#define MFMA_SETTLE4(a) asm volatile("s_nop 15\n\ts_nop 7" : "+v"(a))
#define MFMA_SETTLE16(a) asm volatile("s_nop 15\n\ts_nop 15" : "+v"(a))
constexpr int DM = 1024, FF = 4096, MP = 16384, MS = 512, MT = MP + MS, SEQ = 8192;
constexpr float EPS = 1e-6f;

typedef __bf16 bf16x2_t __attribute__((ext_vector_type(2)));
__device__ __forceinline__ unsigned cvt_pk_bf16(float lo, float hi) { f32x2 v = {lo, hi}; bf16x2_t b = __builtin_convertvector(v, bf16x2_t); return __builtin_bit_cast(unsigned, b); }
__device__ __forceinline__ void store16_sc1(void* p, u32x4 v) { asm volatile("global_store_dwordx4 %0, %1, off sc1" :: "v"(p), "v"(v) : "memory"); }
__device__ __forceinline__ float bf2f(unsigned short u) { return __uint_as_float(((unsigned)u) << 16); }
__device__ __forceinline__ float bflo(unsigned w) { return __uint_as_float(w << 16); }
__device__ __forceinline__ float bfhi(unsigned w) { return __uint_as_float(w & 0xffff0000u); }
__device__ __forceinline__ unsigned short f2bf(float f) { return (unsigned short)(cvt_pk_bf16(f, 0.f) & 0xffffu); }
__device__ __forceinline__ float wave_sum(float v) {
#pragma unroll
    for (int o = 1; o < 64; o <<= 1) v += __shfl_xor(v, o);
    return v;
}
__device__ __forceinline__ float wave_max(float v) {
#pragma unroll
    for (int o = 1; o < 64; o <<= 1) v = fmaxf(v, __shfl_xor(v, o));
    return v;
}

namespace pg8 {
#define PG8_LAS __attribute__((address_space(3)))
constexpr int BM = 256, BK = 64, HALF = 128, HTB = HALF * BK * 2  , STAGE_BYTES = 8 * HTB, NXCD = 8, WGM = 8;

__host__ __device__ __forceinline__ int lds_byte(int r, int c) { const int st = (r >> 4) * 2 + (c >> 5), rr = r & 15, cc = c & 31, ob = rr * 64 + cc * 2; return st * 1024 + (ob ^ (((ob >> 9) & 1) << 5)); }
__host__ __device__ __forceinline__ void stage_rc(int b, int& R, int& C) { const int st = b / 1024, sb = b % 1024, swz = sb ^ (((sb >> 9) & 1) << 5); R = (st >> 1) * 16 + swz / 64; C = (st & 1) * 32 + (swz % 64) / 2; }
__host__ __device__ __forceinline__ int perm32(int rho) { const int n = rho >> 4, i = rho & 15; return 8 * (i >> 2) + 4 * n + (i & 3); }

struct Unit { int pm, pn, ks, nt; };
struct Gemm { const bf16_t* A; const bf16_t* Bt; int M, N, K, lda, ldb, acol; };

struct StaticOrder {
    int nM, nN, nwg, G, c;
    __host__ __device__ void init(int M, int N, int G_, int c_) { nM = M / BM; nN = N / BM; nwg = nM * nN; G = G_; c = c_; }
    __host__ __device__ bool next(int i, Unit& u) const {
        const long L = (long)i * G + c; if (L >= nwg) return false;
        int wgid = (int)L; { const int q = nwg / NXCD, r = nwg % NXCD, xcd = wgid % NXCD, off = wgid / NXCD; wgid = (xcd < r ? xcd * (q + 1) : r * (q + 1) + (xcd - r) * q) + off; }
        const int nig = WGM * nN, gid = wgid / nig, fm = gid * WGM, gsz = (nM - fm) < WGM ? (nM - fm) : WGM;
        u.pm = fm + ((wgid % nig) % gsz); u.pn = (wgid % nig) / gsz; u.ks = 0; u.nt = 0; return true;
    }
    __device__ __forceinline__ void a_ready(const Unit&) const {}
    __device__ __forceinline__ void done(const Unit&) const {}
};
constexpr int KSLICE = 256;
struct DownOrder {
    StaticOrder so; int G, c, S;
    __host__ __device__ bool next(int i, Unit& u) const {
        const int L = i * G + c;
        if (L < 256) { StaticOrder t = so; t.G = 256; t.c = L; return t.next(0, u); }
        const int q = L - 256; if (q >= 8 * S) return false;
        u.ks = q >> 3; u.pm = 64 + ((q >> 2) & 1); u.pn = q & 3; u.nt = KSLICE / BK; return true;
    }
    __device__ __forceinline__ void a_ready(const Unit&) const {}
    __device__ __forceinline__ void done(const Unit&) const {}
};
template <class Epi, class Sched, bool ALIGN_EPI = false, bool SP2 = false>
__device__ __forceinline__ void gemm_phase(PG8_LAS unsigned char* lds, const Gemm g, const Sched& S, const Epi& E) {
    int tid_l = threadIdx.x; asm volatile("" : "+v"(tid_l));
    const int tid = tid_l, wid = __builtin_amdgcn_readfirstlane(tid >> 6), lane = tid & 63, wr = wid >> 2, wc = wid & 3, fr = lane & 15, fq = lane >> 4;
    const int K = g.K; int nt = K / BK;
    unsigned voffA[2], voffB[2];
#pragma unroll
    for (int i = 0; i < 2; ++i) { int R, C; stage_rc(tid * 16 + i * 8192, R, C); const int Rb = Epi::PERM ? ((R & ~31) + perm32(R & 31)) : R;
        voffA[i] = (unsigned)(R * g.lda + C) * 2u; voffB[i] = (unsigned)(Rb * g.ldb + C) * 2u; }
    const size_t kstep = (size_t)(BK * 2);
    const size_t hstepA = (size_t)HALF * g.lda * 2, hstepB = (size_t)HALF * g.ldb * 2;
    const size_t tstepA = 2 * hstepA, tstepB = 2 * hstepB, acolb = (size_t)g.acol * 2;
    const unsigned ldsw = (unsigned)wid * 1024u;
    const int aoff = lds_byte(wr * 64 + fr, fq * 8), boff = lds_byte(wc * 32 + fr, fq * 8);
#define PG8_SA(b, h) (((b) * 2 + (h)) * HTB)
#define PG8_SB(b, h) ((4 + (b) * 2 + (h)) * HTB)
#define PG8_STAGE(bufoff, gbase, voff) do { _Pragma("unroll") for (int _i = 0; _i < 2; ++_i) \
        __builtin_amdgcn_global_load_lds((const unsigned*)((const char*)(gbase) + (voff)[_i]), (PG8_LAS unsigned*)(lds + (bufoff) + ldsw + _i * 8192), 16, 0, 0); } while (0)
#define PG8_LDA(dst, b, h) do { _Pragma("unroll") for (int m = 0; m < 4; ++m) _Pragma("unroll") for (int k = 0; k < 2; ++k) dst[m][k] = *(const PG8_LAS bf16x8*)(lds + PG8_SA(b, h) + aoff + m * 2048 + k * 1024); } while (0)
#define PG8_LDB(dst, b, h) do { _Pragma("unroll") for (int n = 0; n < 2; ++n) _Pragma("unroll") for (int k = 0; k < 2; ++k) dst[n][k] = *(const PG8_LAS bf16x8*)(lds + PG8_SB(b, h) + boff + n * 2048 + k * 1024); } while (0)
#define PG8_MMA(ai, bj, At, Bt) do { __builtin_amdgcn_s_setprio(1); _Pragma("unroll") for (int m = 0; m < 4; ++m) _Pragma("unroll") for (int n = 0; n < 2; ++n) _Pragma("unroll") for (int k = 0; k < 2; ++k) \
        acc[ai][bj][m][n] = __builtin_amdgcn_mfma_f32_16x16x32_bf16(Bt[n][k], At[m][k], acc[ai][bj][m][n], 0, 0, 0); __builtin_amdgcn_s_setprio(0); } while (0)
#define PG8_WAIT_V(n) asm volatile("s_waitcnt vmcnt(" #n ")" ::: "memory")
#define PG8_WAIT_L(n) asm volatile("s_waitcnt lgkmcnt(" #n ")" ::: "memory")
#define PG8_BAR __builtin_amdgcn_s_barrier()
#define PG8_SCHED __builtin_amdgcn_sched_barrier(0)
    Unit cur, nxt; int ui = 0;
    if (!S.next(0, cur)) return;
    f32x4 acc[2][2][4][2];
#pragma unroll
    for (int a = 0; a < 2; ++a)
#pragma unroll
        for (int b = 0; b < 2; ++b)
#pragma unroll
            for (int m = 0; m < 4; ++m)
#pragma unroll
                for (int n = 0; n < 2; ++n) acc[a][b][m][n] = (f32x4){0.f, 0.f, 0.f, 0.f};
    bf16x8 At[4][2], B0[2][2], B1[2][2];
    if (cur.nt) nt = cur.nt;
    const size_t ksb = (size_t)KSLICE * 2;
    const char* cA = (const char*)g.A + (size_t)cur.pm * tstepA + (size_t)cur.pn * acolb + (size_t)cur.ks * ksb; const char* cB = (const char*)g.Bt + (size_t)cur.pn * tstepB + (size_t)cur.ks * ksb;
    S.a_ready(cur);
    if constexpr (SP2) {
        PG8_STAGE(PG8_SB(0, 0), cB, voffB); PG8_STAGE(PG8_SB(0, 1), cB + hstepB, voffB); PG8_STAGE(PG8_SA(0, 0), cA, voffA); PG8_STAGE(PG8_SA(0, 1), cA + hstepA, voffA);
        if (wr == 1) PG8_BAR;
        PG8_WAIT_V(2); PG8_BAR;
        PG8_STAGE(PG8_SB(1, 0), cB + kstep, voffB); PG8_STAGE(PG8_SA(1, 0), cA + kstep, voffA); PG8_STAGE(PG8_SB(1, 1), cB + hstepB + kstep, voffB);
        PG8_WAIT_V(6); PG8_BAR;
    } else {
        PG8_STAGE(PG8_SB(0, 0), cB, voffB); PG8_STAGE(PG8_SA(0, 0), cA, voffA); PG8_STAGE(PG8_SB(0, 1), cB + hstepB, voffB); PG8_STAGE(PG8_SA(0, 1), cA + hstepA, voffA);
        if (wr == 1) PG8_BAR;
        PG8_WAIT_V(4); PG8_BAR;
        PG8_STAGE(PG8_SB(1, 0), cB + kstep, voffB); PG8_STAGE(PG8_SA(1, 0), cA + kstep, voffA); PG8_STAGE(PG8_SB(1, 1), cB + hstepB + kstep, voffB);
        PG8_WAIT_V(6); PG8_BAR;
    }
    for (;;) {
        const bool has_next = S.next(ui + 1, nxt);
        const char* nA = has_next ? (const char*)g.A + (size_t)nxt.pm * tstepA + (size_t)nxt.pn * acolb + (size_t)nxt.ks * ksb : cA; const char* nB = has_next ? (const char*)g.Bt + (size_t)nxt.pn * tstepB + (size_t)nxt.ks * ksb : cB;
        for (int t = 0; t < nt; t += 2) {
            const bool last = (t == nt - 2);
            const char* a1 = cA + (size_t)(t + 1) * kstep;
            const char* a2 = last ? nA : cA + (size_t)(t + 2) * kstep; const char* b2 = last ? nB : cB + (size_t)(t + 2) * kstep;
            const char* a3 = a2 + kstep; const char* b3 = b2 + kstep;
            if (last && has_next) S.a_ready(nxt);
            if constexpr (SP2) {
            PG8_LDB(B0, 0, 0); PG8_LDB(B1, 0, 1); PG8_SCHED; PG8_LDA(At, 0, 0); PG8_STAGE(PG8_SA(1, 1), a1 + hstepA, voffA);
            PG8_WAIT_V(8); PG8_WAIT_L(0); PG8_BAR; PG8_MMA(0, 0, At, B0); PG8_MMA(0, 1, At, B1); PG8_BAR; PG8_SCHED;
            PG8_LDA(At, 0, 1); PG8_STAGE(PG8_SB(0, 0), b2, voffB); PG8_STAGE(PG8_SB(0, 1), b2 + hstepB, voffB); PG8_STAGE(PG8_SA(0, 0), a2, voffA);
            PG8_WAIT_V(8); PG8_WAIT_L(0); PG8_BAR; PG8_MMA(1, 0, At, B0); PG8_MMA(1, 1, At, B1); PG8_BAR; PG8_SCHED;
            PG8_LDB(B0, 1, 0); PG8_LDB(B1, 1, 1); PG8_SCHED; PG8_LDA(At, 1, 0); PG8_STAGE(PG8_SA(0, 1), a2 + hstepA, voffA);
            PG8_WAIT_V(8); PG8_WAIT_L(0); PG8_BAR; PG8_MMA(0, 0, At, B0); PG8_MMA(0, 1, At, B1); PG8_BAR; PG8_SCHED;
            PG8_LDA(At, 1, 1); PG8_STAGE(PG8_SB(1, 0), b3, voffB); PG8_STAGE(PG8_SB(1, 1), b3 + hstepB, voffB); PG8_STAGE(PG8_SA(1, 0), a3, voffA);
            PG8_WAIT_V(8); PG8_WAIT_L(0); PG8_BAR; PG8_MMA(1, 0, At, B0); PG8_MMA(1, 1, At, B1); PG8_BAR; PG8_SCHED;
            } else {
            PG8_LDB(B0, 0, 0); PG8_SCHED; PG8_LDA(At, 0, 0); PG8_STAGE(PG8_SA(1, 1), a1 + hstepA, voffA);
            PG8_WAIT_L(8); PG8_BAR; PG8_WAIT_L(0); PG8_MMA(0, 0, At, B0); PG8_BAR; PG8_SCHED;
            PG8_LDB(B1, 0, 1); PG8_STAGE(PG8_SB(0, 0), b2, voffB);
            PG8_BAR; PG8_WAIT_L(0); PG8_MMA(0, 1, At, B1); PG8_BAR;
            PG8_LDA(At, 0, 1); PG8_STAGE(PG8_SA(0, 0), a2, voffA);
            PG8_BAR; PG8_WAIT_L(0); PG8_MMA(1, 0, At, B0); PG8_BAR; PG8_SCHED;
            PG8_STAGE(PG8_SB(0, 1), b2 + hstepB, voffB);
            PG8_WAIT_V(6); PG8_BAR; PG8_MMA(1, 1, At, B1); PG8_BAR;
            PG8_LDB(B0, 1, 0); PG8_SCHED; PG8_LDA(At, 1, 0); PG8_STAGE(PG8_SA(0, 1), a2 + hstepA, voffA);
            PG8_WAIT_L(8); PG8_BAR; PG8_WAIT_L(0); PG8_MMA(0, 0, At, B0); PG8_BAR; PG8_SCHED;
            PG8_LDB(B1, 1, 1); PG8_STAGE(PG8_SB(1, 0), b3, voffB);
            PG8_BAR; PG8_WAIT_L(0); PG8_MMA(0, 1, At, B1); PG8_BAR;
            PG8_LDA(At, 1, 1); PG8_STAGE(PG8_SA(1, 0), a3, voffA);
            PG8_BAR; PG8_WAIT_L(0); PG8_MMA(1, 0, At, B0); PG8_BAR; PG8_SCHED;
            PG8_STAGE(PG8_SB(1, 1), b3 + hstepB, voffB);
            PG8_WAIT_V(6); PG8_BAR; PG8_MMA(1, 1, At, B1); PG8_BAR;
            }
        }
        if constexpr (ALIGN_EPI) { if (wr == 0) PG8_BAR; }
        if constexpr (!Epi::AFTER_DRAIN) { E(acc, cur, wr, wc, fr, fq); S.done(cur); }
        if (!has_next) break;
#pragma unroll
        for (int a = 0; a < 2; ++a)
#pragma unroll
            for (int b = 0; b < 2; ++b)
#pragma unroll
                for (int m = 0; m < 4; ++m)
#pragma unroll
                    for (int n = 0; n < 2; ++n) acc[a][b][m][n] = (f32x4){0.f, 0.f, 0.f, 0.f};
        cur = nxt; cA = nA; cB = nB; ++ui; nt = cur.nt ? cur.nt : K / BK;
        if constexpr (ALIGN_EPI) { if (wr == 1) PG8_BAR; }
    }
    PG8_WAIT_V(0);
    if constexpr (!ALIGN_EPI) { if (wr == 0) PG8_BAR; }
    PG8_BAR;
    if constexpr (Epi::AFTER_DRAIN) { E.fused(acc, cur, wr, wc, fr, fq, lds, wid, lane); S.done(cur); }
#undef PG8_SA
#undef PG8_SB
#undef PG8_STAGE
#undef PG8_LDA
#undef PG8_LDB
#undef PG8_MMA
#undef PG8_WAIT_V
#undef PG8_WAIT_L
#undef PG8_BAR
#undef PG8_SCHED
}
}

using pg8::Unit;
constexpr size_t MiB = 1u << 20;
constexpr size_t WS_SSQ = 0;
constexpr size_t WS_LB = 1280 * 1024;
constexpr size_t WS_ROPE = 1536 * 1024;
constexpr size_t WS_DC = 2560 * 1024;
constexpr size_t WS_W = 4 * MiB;
constexpr size_t W_UP0 = WS_W, W_DN0 = W_UP0 + 8 * MiB, W_UP1 = W_DN0 + 8 * MiB, W_DN1 = W_UP1 + 8 * MiB;
constexpr size_t W_QKV = W_DN1 + 8 * MiB, W_SWO = W_QKV + 3 * MiB, W_POOL0 = W_SWO + 2 * MiB;
constexpr size_t WS_GATE = WS_W;
constexpr size_t W_HG = WS_W + 38 * MiB, W_HGO = W_HG + 8 * MiB, W_UP2 = W_HGO + 2 * MiB, W_DN2 = W_UP2 + 8 * MiB, W_UP3 = W_DN2 + 8 * MiB, W_DN3 = W_UP3 + 8 * MiB, W_POOL1 = W_DN3 + 8 * MiB;
constexpr size_t WS_HB = WS_W + 81 * MiB;
constexpr size_t WS_R = WS_HB + 33 * MiB;
constexpr size_t R_HID = WS_R;
constexpr size_t R_D = WS_R;
constexpr size_t R_Q = WS_R, R_K = WS_R + 33 * MiB, R_V = R_K + 9 * MiB, R_O = R_V + 9 * MiB;
constexpr size_t R_LG = WS_R, R_HV = R_LG + 66 * MiB, R_HQ = R_HV + 33 * MiB, R_DS = R_HQ + 33 * MiB;
constexpr size_t WS_END = R_DS + 64 * MiB;
static_assert(W_POOL0 + MiB / 2 <= W_HG && WS_GATE + 33 * MiB <= W_HG && W_POOL1 + MiB / 2 <= WS_HB, "weights map");

constexpr size_t O_Y = 0, O_POOLP = (size_t)MT * DM, O_POOLS = O_POOLP + 2 * 2 * 15 * 1024, O_KP = O_POOLS + (size_t)2 * 128 * 15 * 1024,
                 O_KS = O_KP + 2 * 128 * 256, O_VP = O_KS + (size_t)128 * 128 * 256, O_VS = O_VP + 2 * 128 * 256, O_HP = O_VS + (size_t)128 * 128 * 256, O_HS = O_HP + 2 * 8 * 128 * 128;

constexpr int LDS_BYTES = 147456;

__device__ __forceinline__ float row_rinv(const float* ssq, int row) {
    const f32x4* p = (const f32x4*)(ssq + (size_t)row * 16);
    const f32x4 a = p[0], b = p[1], c = p[2], d = p[3];
    const float s = ((a.x + a.y) + (a.z + a.w)) + ((b.x + b.y) + (b.z + b.w)) + ((c.x + c.y) + (c.z + c.w)) + ((d.x + d.y) + (d.z + d.w));
    return rsqrtf(s * (1.f / 1024.f) + EPS);
}

struct EpiResid {
    static constexpr bool PERM = false, AFTER_DRAIN = false;
    const float* src_p; const float* src_s; float* h; bf16_t* hb; float* ssq; const float* cscale;
    __device__ __forceinline__ void operator()(const f32x4 (&acc)[2][2][4][2], const Unit& u, int wr, int wc, int fr, int fq) const {
        const int col0 = u.pn * 256 + wc * 32 + 4 * fq;
        f32x4 cs[2][2];
#pragma unroll
        for (int bj = 0; bj < 2; ++bj)
#pragma unroll
            for (int n = 0; n < 2; ++n) cs[bj][n] = cscale ? *(const f32x4*)(cscale + col0 + bj * 128 + n * 16) : (f32x4){1.f, 1.f, 1.f, 1.f};
#pragma unroll
        for (int ai = 0; ai < 2; ++ai)
#pragma unroll
            for (int m = 0; m < 4; ++m) {
                const int row = u.pm * 256 + ai * 128 + wr * 64 + m * 16 + fr;
                const float* sp = (row < MP ? src_p + (size_t)row * DM : src_s + (size_t)(row - MP) * DM) + col0;
                float* hp = h + (size_t)row * DM + col0; bf16_t* bp = hb + (size_t)row * DM + col0;
                float s = 0.f;
#pragma unroll
                for (int bj = 0; bj < 2; ++bj)
#pragma unroll
                    for (int n = 0; n < 2; ++n) {
                        const int off = bj * 128 + n * 16;
                        const f32x4 o = *(const f32x4*)(sp + off) + acc[ai][bj][m][n] * cs[bj][n];
                        *(f32x4*)(hp + off) = o;
                        u32x2 w; w.x = cvt_pk_bf16(o.x, o.y); w.y = cvt_pk_bf16(o.z, o.w); *(u32x2*)(bp + off) = w;
                        s += (o.x * o.x + o.y * o.y) + (o.z * o.z + o.w * o.w);
                    }
                s += __shfl_xor(s, 16); s += __shfl_xor(s, 32);
                if (fq == 0) ssq[(size_t)row * 16 + u.pn * 4 + wc] = s;
            }
    }
};
struct EpiPartial {
    static constexpr bool PERM = false, AFTER_DRAIN = false;
    float* P;
    __device__ __forceinline__ void operator()(const f32x4 (&acc)[2][2][4][2], const Unit& u, int wr, int wc, int fr, int fq) const {
        float* tp = P + (size_t)((u.ks * 8 + (u.pm - 64) * 4 + u.pn)) * 65536 + wc * 32 + 4 * fq;
#pragma unroll
        for (int ai = 0; ai < 2; ++ai)
#pragma unroll
            for (int m = 0; m < 4; ++m) {
                float* rp = tp + (ai * 128 + wr * 64 + m * 16 + fr) * 256;
#pragma unroll
                for (int bj = 0; bj < 2; ++bj)
#pragma unroll
                    for (int n = 0; n < 2; ++n) *(f32x4*)(rp + bj * 128 + n * 16) = acc[ai][bj][m][n];
            }
    }
};
struct EpiDown {
    static constexpr bool PERM = false, AFTER_DRAIN = false;
    EpiResid R; EpiPartial A;
    __device__ __forceinline__ void operator()(const f32x4 (&acc)[2][2][4][2], const Unit& u, int wr, int wc, int fr, int fq) const {
        if (u.nt) A(acc, u, wr, wc, fr, fq); else R(acc, u, wr, wc, fr, fq);
    }
};
struct EpiFfnUp {
    static constexpr bool PERM = true, AFTER_DRAIN = false;
    bf16_t* hid; const float* ssq;
    __device__ __forceinline__ void operator()(const f32x4 (&acc)[2][2][4][2], const Unit& u, int wr, int wc, int fr, int fq) const {
        const int col0 = u.pn * 256 + wc * 32 + 8 * fq;
#pragma unroll
        for (int ai = 0; ai < 2; ++ai)
#pragma unroll
            for (int m = 0; m < 4; ++m) {
                const int row = u.pm * 256 + ai * 128 + wr * 64 + m * 16 + fr;
                const float r = row_rinv(ssq, row);
                bf16_t* rp = hid + (size_t)row * FF + col0;
#pragma unroll
                for (int bj = 0; bj < 2; ++bj) {
                    f32x4 v0 = acc[ai][bj][m][0] * r, v1 = acc[ai][bj][m][1] * r;
#pragma unroll
                    for (int e = 0; e < 4; ++e) { const float a = fmaxf(v0[e], 0.f), b = fmaxf(v1[e], 0.f); v0[e] = a * a; v1[e] = b * b; }
                    u32x4 w; w.x = cvt_pk_bf16(v0[0], v0[1]); w.y = cvt_pk_bf16(v0[2], v0[3]); w.z = cvt_pk_bf16(v1[0], v1[1]); w.w = cvt_pk_bf16(v1[2], v1[3]);
                    *(u32x4*)(rp + bj * 128) = w;
                }
            }
    }
};
struct EpiQKV {
    static constexpr bool PERM = true, AFTER_DRAIN = false;
    bf16_t* Q; bf16_t* K; bf16_t* V; const float* ssq; const float* rope; float* okp; float* oks; float* ovp; float* ovs;
    __device__ __forceinline__ void operator()(const f32x4 (&acc)[2][2][4][2], const Unit& u, int wr, int wc, int fr, int fq) const {
        const int cl0 = wc * 32 + 8 * fq;
        const bool dorope = (u.pn <= 4) && ((wc & 1) == 0);
#pragma unroll
        for (int ai = 0; ai < 2; ++ai)
#pragma unroll
            for (int m = 0; m < 4; ++m) {
                const int row = u.pm * 256 + ai * 128 + wr * 64 + m * 16 + fr;
                const float r = row_rinv(ssq, row);
                const int pos = row < MP ? (row & (SEQ - 1)) : SEQ + ((row - MP) & 3);
                f32x4 cs[4];
                if (dorope) {
#pragma unroll
                    for (int e = 0; e < 4; ++e) cs[e] = *(const f32x4*)(rope + (size_t)pos * 16 + 4 * e);
                }
#pragma unroll
                for (int bj = 0; bj < 2; ++bj) {
                    f32x4 v0 = acc[ai][bj][m][0] * r, v1 = acc[ai][bj][m][1] * r;
                    if (dorope) {
                        f32x4 p0, p1;
#pragma unroll
                        for (int e = 0; e < 4; ++e) { p0[e] = __shfl_xor(v0[e], 16); p1[e] = __shfl_xor(v1[e], 16); }
                        if (fq < 2) {
                            const float sg = fq == 0 ? -1.f : 1.f;
                            v0[0] = v0[0] * cs[0][0] + sg * p0[0] * cs[0][1]; v0[1] = v0[1] * cs[0][2] + sg * p0[1] * cs[0][3];
                            v0[2] = v0[2] * cs[1][0] + sg * p0[2] * cs[1][1]; v0[3] = v0[3] * cs[1][2] + sg * p0[3] * cs[1][3];
                            v1[0] = v1[0] * cs[2][0] + sg * p1[0] * cs[2][1]; v1[1] = v1[1] * cs[2][2] + sg * p1[1] * cs[2][3];
                            v1[2] = v1[2] * cs[3][0] + sg * p1[2] * cs[3][1]; v1[3] = v1[3] * cs[3][2] + sg * p1[3] * cs[3][3];
                        }
                    }
                    u32x4 w; w.x = cvt_pk_bf16(v0[0], v0[1]); w.y = cvt_pk_bf16(v0[2], v0[3]); w.z = cvt_pk_bf16(v1[0], v1[1]); w.w = cvt_pk_bf16(v1[2], v1[3]);
                    const int cl = cl0 + bj * 128;
                    if (u.pn < 4) *(u32x4*)(Q + (size_t)row * DM + u.pn * 256 + cl) = w;
                    else {
                        bf16_t* dst = (u.pn == 4 ? K : V) + (size_t)row * 256 + cl; *(u32x4*)dst = w;
                        float* o = nullptr;
                        if (row < MP) { const int t = row & (SEQ - 1); if (t >= SEQ - 128) o = (u.pn == 4 ? okp : ovp) + ((size_t)(row >> 13) * 128 + (t - (SEQ - 128))) * 256 + cl; }
                        else { const int n = (row - MP) >> 2, i = (row - MP) & 3; o = (u.pn == 4 ? oks : ovs) + ((size_t)n * 128 + 124 + i) * 256 + cl; }
                        if (o) { *(f32x4*)o = v0; *(f32x4*)(o + 4) = v1; }
                    }
                }
            }
    }
};
struct EpiHg {
    static constexpr bool PERM = true, AFTER_DRAIN = false;
    float* LG; bf16_t* HV; bf16_t* HQ; bf16_t* GATE; const float* ssq; const float* lb;
    __device__ __forceinline__ void operator()(const f32x4 (&acc)[2][2][4][2], const Unit& u, int wr, int wc, int fr, int fq) const {
        const int type = u.pn >> 2, c0 = (u.pn & 3) * 256 + wc * 32 + 8 * fq;
        f32x4 lbv[2][2];
        if (type == 0) {
#pragma unroll
            for (int bj = 0; bj < 2; ++bj) { lbv[bj][0] = *(const f32x4*)(lb + c0 + bj * 128); lbv[bj][1] = *(const f32x4*)(lb + c0 + bj * 128 + 4); }
        }
#pragma unroll
        for (int ai = 0; ai < 2; ++ai)
#pragma unroll
            for (int m = 0; m < 4; ++m) {
                const int row = u.pm * 256 + ai * 128 + wr * 64 + m * 16 + fr;
                const float r = row_rinv(ssq, row);
#pragma unroll
                for (int bj = 0; bj < 2; ++bj) {
                    f32x4 v0 = acc[ai][bj][m][0] * r, v1 = acc[ai][bj][m][1] * r;
                    const int c = c0 + bj * 128;
                    if (type == 0) {
#pragma unroll
                        for (int e = 0; e < 4; ++e) {
                            const float s0 = 1.f / (1.f + __expf(-v0[e])), s1 = 1.f / (1.f + __expf(-v1[e]));
                            v0[e] = __logf(lbv[bj][0][e] + (1.f - lbv[bj][0][e]) * s0); v1[e] = __logf(lbv[bj][1][e] + (1.f - lbv[bj][1][e]) * s1);
                        }
                        float* o = LG + (size_t)row * DM + c; *(f32x4*)o = v0; *(f32x4*)(o + 4) = v1;
                    } else {
                        if (type >= 2) {
#pragma unroll
                            for (int e = 0; e < 4; ++e) { v0[e] = v0[e] / (1.f + __expf(-v0[e])); v1[e] = v1[e] / (1.f + __expf(-v1[e])); }
                        }
                        u32x4 w; w.x = cvt_pk_bf16(v0[0], v0[1]); w.y = cvt_pk_bf16(v0[2], v0[3]); w.z = cvt_pk_bf16(v1[0], v1[1]); w.w = cvt_pk_bf16(v1[2], v1[3]);
                        bf16_t* dst = (type == 1 ? HV : type == 2 ? HQ : GATE) + (size_t)row * DM + c;
                        *(u32x4*)dst = w;
                    }
                }
            }
    }
};

__device__ __forceinline__ void transpose_item(const float* W, int K, int N, const float* gain, bf16_t* WT, int ldk, int row_off, LAS float* scr, int item, int lane) {
    const int nblk = N / 32, kb = item / nblk, nb = item % nblk, k0 = 64 * kb, n0 = 32 * nb;
    float v[32];
#pragma unroll
    for (int i = 0; i < 32; ++i) v[i] = W[(size_t)(k0 + 2 * i + (lane >> 5)) * N + n0 + (lane & 31)];
    if (gain) {
#pragma unroll
        for (int i = 0; i < 32; ++i) v[i] *= gain[k0 + 2 * i + (lane >> 5)];
    }
#pragma unroll
    for (int i = 0; i < 32; ++i) scr[(2 * i + (lane >> 5)) * 33 + (lane & 31)] = v[i];
    asm volatile("s_waitcnt lgkmcnt(0)" ::: "memory");
    const int c = lane & 7;
#pragma unroll
    for (int j = 0; j < 4; ++j) { const int n = (lane >> 3) + 8 * j; const LAS float* s = scr + (8 * c) * 33 + n;
        u32x4 o; o.x = cvt_pk_bf16(s[0 * 33], s[1 * 33]); o.y = cvt_pk_bf16(s[2 * 33], s[3 * 33]); o.z = cvt_pk_bf16(s[4 * 33], s[5 * 33]); o.w = cvt_pk_bf16(s[6 * 33], s[7 * 33]);
        *(u32x4*)(WT + (size_t)(row_off + n0 + n) * ldk + k0 + 8 * c) = o; }
    asm volatile("s_waitcnt lgkmcnt(0)" ::: "memory");
}

struct Args { const float* in[25]; float* out; unsigned char* ws; };

template <bool SAMPLE>
__device__ __forceinline__ void pool_unit(const float* src_p, const float* src_s, const float* gmix, const float* buf, bf16_t* dbuf, float* opool, int unit, LAS float* rl, int tid, int wave, int lane) {
    const int b = unit >> 7, t0 = (unit & 127) * 64;
    const int nr = SAMPLE ? 4 : 79;
    for (int rr = wave; rr < nr; rr += 8) {
        const int t = SAMPLE ? rr : t0 - 15 + rr;
        float r = 0.f;
        if (SAMPLE || t >= 0) {
            const f32x4* xr = (const f32x4*)(SAMPLE ? src_s + (size_t)(unit * 4 + rr) * DM : src_p + (size_t)(b * SEQ + t) * DM) + lane;
            float s = 0.f;
#pragma unroll
            for (int j = 0; j < 4; ++j) { const f32x4 v = xr[64 * j]; s += (v.x * v.x + v.y * v.y) + (v.z * v.z + v.w * v.w); }
            r = rsqrtf(wave_sum(s) * (1.f / 1024.f) + EPS);
        }
        if (lane == 0) rl[rr] = r;
    }
    __syncthreads();
    const int cq = tid & 255, half = tid >> 8;
    if (!SAMPLE || half == 0) {
        const int w = 2 << (cq >> 6);
        const f32x4 g4 = *(const f32x4*)(gmix + 4 * cq);
        f32x4 ring[16];
#pragma unroll
        for (int it = 0; it < (SAMPLE ? 19 : 47); ++it) {
            f32x4 uv; int t;
            if (SAMPLE) {
                t = it - 15;
                if (it < 15) uv = *(const f32x4*)(buf + ((size_t)unit * 15 + it) * DM + 4 * cq);
                else uv = *(const f32x4*)(src_s + (size_t)(unit * 4 + t) * DM + 4 * cq) * rl[t] * g4;
            } else {
                const int rr = 32 * half + it; t = t0 - 15 + rr;
                uv = (f32x4){0.f, 0.f, 0.f, 0.f};
                if (t >= 0) uv = *(const f32x4*)(src_p + (size_t)(b * SEQ + t) * DM + 4 * cq) * rl[rr] * g4;
            }
            ring[it & 15] = uv;
            if (it >= 15) {
                const f32x4 s2 = ring[it & 15] + ring[(it - 1) & 15];
                const f32x4 s4 = s2 + (ring[(it - 2) & 15] + ring[(it - 3) & 15]);
                const f32x4 s8 = s4 + ((ring[(it - 4) & 15] + ring[(it - 5) & 15]) + (ring[(it - 6) & 15] + ring[(it - 7) & 15]));
                const f32x4 s16 = s8 + (((ring[(it - 8) & 15] + ring[(it - 9) & 15]) + (ring[(it - 10) & 15] + ring[(it - 11) & 15])) + ((ring[(it - 12) & 15] + ring[(it - 13) & 15]) + (ring[(it - 14) & 15] + ring[(it - 15) & 15])));
                const f32x4 s = w == 2 ? s2 : w == 4 ? s4 : w == 8 ? s8 : s16;
                const int cnt = SAMPLE ? w : (t + 1 < w ? t + 1 : w);
                const f32x4 d = s * (1.f / (float)cnt) - uv;
                const size_t row = SAMPLE ? (size_t)MP + unit * 4 + t : (size_t)b * SEQ + t;
                u32x2 pk; pk.x = cvt_pk_bf16(d.x, d.y); pk.y = cvt_pk_bf16(d.z, d.w);
                *(u32x2*)(dbuf + row * DM + 4 * cq) = pk;
            }
            if (SAMPLE) { if (it >= 4) *(f32x4*)(opool + ((size_t)unit * 15 + (it - 4)) * DM + 4 * cq) = uv; }
            else { if (t >= SEQ - 15) *(f32x4*)(opool + ((size_t)b * 15 + (t - (SEQ - 15))) * DM + 4 * cq) = uv; }
        }
    }
    __syncthreads();
}

__device__ __forceinline__ int crow(int r, int hi) { return (r & 3) + 8 * (r >> 2) + 4 * hi; }
__device__ __forceinline__ f32x16 attn_scores(const bf16_t* K, size_t rowbase, int q0, int j, int kvh, const bf16x8 (&qf)[4], int r32, int hi) {
    int krow = q0 - 128 + 32 * j + r32; krow = krow < 0 ? 0 : krow;
    const bf16_t* kp = K + (rowbase + krow) * 256 + kvh * 64 + hi * 8;
    f32x16 p = {};
#pragma unroll
    for (int d0 = 0; d0 < 4; ++d0) { const bf16x8 a = *(const bf16x8*)(kp + d0 * 16); p = __builtin_amdgcn_mfma_f32_32x32x16_bf16(a, qf[d0], p, 0, 0, 0); }
    MFMA_SETTLE16(p);
    const int qp = q0 + r32;
#pragma unroll
    for (int r = 0; r < 16; ++r) {
        const int kpos = q0 - 128 + 32 * j + crow(r, hi);
        const bool ok = (kpos >= 0) && (kpos <= qp) && (kpos >= qp - 128);
        p[r] = ok ? p[r] * 0.125f : -INFINITY;
    }
    return p;
}
__device__ __forceinline__ void attn_prompt_unit(const bf16_t* Q, const bf16_t* K, const bf16_t* V, bf16_t* O, const float* sinks, int unit, int wave, int lane) {
    const int kvh = unit & 3, qblk = (unit >> 2) & 127, b = unit >> 9;
    const int h = kvh * 4 + (wave & 3), q0 = qblk * 64 + 32 * (wave >> 2);
    const size_t rowbase = (size_t)b * SEQ;
    const int r32 = lane & 31, hi = lane >> 5;
    bf16x8 qf[4];
#pragma unroll
    for (int d0 = 0; d0 < 4; ++d0) qf[d0] = *(const bf16x8*)(Q + (rowbase + q0 + r32) * DM + h * 64 + d0 * 16 + hi * 8);
    const float sink = sinks[h];
    float mx = sink, l = 1.f;
#pragma unroll 1
    for (int j = 0; j < 5; ++j) {
        const f32x16 p = attn_scores(K, rowbase, q0, j, kvh, qf, r32, hi);
        float tm = p[0];
#pragma unroll
        for (int r = 1; r < 16; ++r) tm = fmaxf(tm, p[r]);
        tm = fmaxf(tm, __shfl_xor(tm, 32));
        const float mn = fmaxf(mx, tm);
        float ts = 0.f;
#pragma unroll
        for (int r = 0; r < 16; ++r) ts += __expf(p[r] - mn);
        ts += __shfl_xor(ts, 32);
        l = l * __expf(mx - mn) + ts; mx = mn;
    }
    const float inv = 1.f / l;
    f32x16 o0 = {}, o1 = {};
#pragma unroll 1
    for (int j = 0; j < 5; ++j) {
        f32x16 p = attn_scores(K, rowbase, q0, j, kvh, qf, r32, hi);
#pragma unroll
        for (int r = 0; r < 16; ++r) p[r] = __expf(p[r] - mx) * inv;
#pragma unroll
        for (int st = 0; st < 2; ++st) {
            u32x4 pw;
            pw.x = cvt_pk_bf16(p[8 * st + 0], p[8 * st + 1]); pw.y = cvt_pk_bf16(p[8 * st + 2], p[8 * st + 3]);
            pw.z = cvt_pk_bf16(p[8 * st + 4], p[8 * st + 5]); pw.w = cvt_pk_bf16(p[8 * st + 6], p[8 * st + 7]);
            const bf16x8 pa = __builtin_bit_cast(bf16x8, pw);
            bf16x8 vb0, vb1;
#pragma unroll
            for (int jj = 0; jj < 8; ++jj) {
                int krow = q0 - 128 + 32 * j + crow(8 * st + jj, hi); krow = krow < 0 ? 0 : krow;
                const bf16_t* vp = V + (rowbase + krow) * 256 + kvh * 64 + r32;
                vb0[jj] = (short)vp[0]; vb1[jj] = (short)vp[32];
            }
            o0 = __builtin_amdgcn_mfma_f32_32x32x16_bf16(pa, vb0, o0, 0, 0, 0);
            o1 = __builtin_amdgcn_mfma_f32_32x32x16_bf16(pa, vb1, o1, 0, 0, 0);
        }
    }
    MFMA_SETTLE16(o0); MFMA_SETTLE16(o1);
#pragma unroll
    for (int r = 0; r < 16; ++r) {
        bf16_t* op = O + (rowbase + q0 + crow(r, hi)) * DM + h * 64 + r32;
        op[0] = f2bf(o0[r]); op[32] = f2bf(o1[r]);
    }
}
__device__ __forceinline__ void attn_sample_wave(int n, int h, const bf16_t* Q, const bf16_t* K, const bf16_t* V, const float* ck, const float* cv, bf16_t* O, const float* sinks, LAS float* wl, int lane) {
    const int kvh = h >> 2; const size_t row0 = (size_t)MP + 4 * n;
    LAS float* wq = wl; LAS float* wp = wl + 256;
#pragma unroll
    for (int i = 0; i < 4; ++i) wq[i * 64 + lane] = bf2f(Q[(row0 + i) * DM + h * 64 + lane]);
    asm volatile("s_waitcnt lgkmcnt(0)" ::: "memory"); __builtin_amdgcn_wave_barrier();
    float sc[3][4];
#pragma unroll
    for (int kk = 0; kk < 3; ++kk) {
        float a0 = 0.f, a1 = 0.f, a2 = 0.f, a3 = 0.f;
        if (kk < 2) {
            const f32x4* kp = (const f32x4*)(ck + (((size_t)n * 128 + lane + 64 * kk) * 4 + kvh) * 64);
#pragma unroll 8
            for (int d4 = 0; d4 < 16; ++d4) { const f32x4 kv = kp[d4];
                const f32x4 q0 = *(const LAS f32x4*)(wq + 4 * d4), q1 = *(const LAS f32x4*)(wq + 64 + 4 * d4), q2 = *(const LAS f32x4*)(wq + 128 + 4 * d4), q3 = *(const LAS f32x4*)(wq + 192 + 4 * d4);
                a0 += (kv.x * q0.x + kv.y * q0.y) + (kv.z * q0.z + kv.w * q0.w); a1 += (kv.x * q1.x + kv.y * q1.y) + (kv.z * q1.z + kv.w * q1.w);
                a2 += (kv.x * q2.x + kv.y * q2.y) + (kv.z * q2.z + kv.w * q2.w); a3 += (kv.x * q3.x + kv.y * q3.y) + (kv.z * q3.z + kv.w * q3.w); }
        } else if (lane < 4) {
            const bf16_t* kp = K + (row0 + lane) * 256 + kvh * 64;
#pragma unroll 2
            for (int d = 0; d < 64; ++d) { const float kv = bf2f(kp[d]); a0 += kv * wq[d]; a1 += kv * wq[64 + d]; a2 += kv * wq[128 + d]; a3 += kv * wq[192 + d]; }
        }
        const float a[4] = {a0, a1, a2, a3};
#pragma unroll
        for (int i = 0; i < 4; ++i) {
            bool ok;
            if (kk < 2) ok = (lane + 64 * kk) >= i; else ok = (lane < 4) && (lane <= i);
            sc[kk][i] = ok ? a[i] * 0.125f : -INFINITY;
        }
    }
    const float sink = sinks[h];
#pragma unroll
    for (int i = 0; i < 4; ++i) {
        float mx = fmaxf(fmaxf(sc[0][i], sc[1][i]), sc[2][i]); mx = fmaxf(wave_max(mx), sink);
        const float e0 = __expf(sc[0][i] - mx), e1 = __expf(sc[1][i] - mx), e2 = __expf(sc[2][i] - mx);
        const float sum = wave_sum(e0 + e1 + e2) + __expf(sink - mx), inv = 1.f / sum;
        wp[i * 132 + lane] = e0 * inv; wp[i * 132 + 64 + lane] = e1 * inv; if (lane < 4) wp[i * 132 + 128 + lane] = e2 * inv;
    }
    asm volatile("s_waitcnt lgkmcnt(0)" ::: "memory"); __builtin_amdgcn_wave_barrier();
    float o[4] = {0.f, 0.f, 0.f, 0.f};
#pragma unroll 16
    for (int j = 0; j < 128; ++j) { const float v = cv[(((size_t)n * 128 + j) * 4 + kvh) * 64 + lane];
#pragma unroll
        for (int i = 0; i < 4; ++i) o[i] += wp[i * 132 + j] * v; }
#pragma unroll
    for (int jj = 0; jj < 4; ++jj) { const float v = bf2f(V[(row0 + jj) * 256 + kvh * 64 + lane]);
#pragma unroll
        for (int i = 0; i < 4; ++i) o[i] += wp[i * 132 + 128 + jj] * v; }
#pragma unroll
    for (int i = 0; i < 4; ++i) O[(row0 + i) * DM + h * 64 + lane] = f2bf(o[i]);
    asm volatile("s_waitcnt lgkmcnt(0)" ::: "memory"); __builtin_amdgcn_wave_barrier();
}

__device__ __forceinline__ f32x4 mma16(const LAS unsigned char* X, int xs, const LAS unsigned char* Y, int ys, int ksteps, f32x4 acc, int fr, int fq) {
    for (int ks = 0; ks < ksteps; ++ks) {
        const bf16x8 xv = *(const LAS bf16x8*)(X + fr * xs + ks * 64 + fq * 16);
        const bf16x8 yv = *(const LAS bf16x8*)(Y + fr * ys + ks * 64 + fq * 16);
        acc = __builtin_amdgcn_mfma_f32_16x16x32_bf16(xv, yv, acc, 0, 0, 0);
    }
    return acc;
}
constexpr int S272 = 272, S144 = 144;
constexpr int L_ST = 0, L_Q0 = 34816, L_QI = 52224, L_KT = 69632, L_A = 113152, L_VT = 122368, L_TOT = 140800, L_SSQ = 142848;
__device__ __forceinline__ void load_vt(LAS unsigned char* lds, const bf16_t* HV, size_t rowt0, int h, int tid) {
    const int s = tid >> 3, vc = (tid & 7) * 16;
    const u32x4* src = (const u32x4*)(HV + (rowt0 + s) * DM + h * 128 + vc);
    const u32x4 a = src[0], b = src[1];
    LAS unsigned short* vt = (LAS unsigned short*)(lds + L_VT);
    const unsigned w[8] = {a.x, a.y, a.z, a.w, b.x, b.y, b.z, b.w};
#pragma unroll
    for (int e = 0; e < 8; ++e) { vt[(vc + 2 * e) * 72 + s] = (unsigned short)(w[e] & 0xffffu); vt[(vc + 2 * e + 1) * 72 + s] = (unsigned short)(w[e] >> 16); }
}
__device__ __forceinline__ void hg_h1_unit(LAS unsigned char* lds, const float* LG, const bf16_t* HV, bf16_t* DS, float* Dc, int unit, int tid, int wave, int lane) {
    const int n = unit >> 10, h = (unit >> 7) & 7, c = unit & 127;
    const size_t rowt0 = (size_t)n * SEQ + c * 64;
    const int k = tid & 127, tq = tid >> 7;
    LAS float* tot = (LAS float*)(lds + L_TOT);
    float lg[16], cs[16];
    float run = 0.f;
#pragma unroll
    for (int i = 0; i < 16; ++i) { lg[i] = LG[(rowt0 + 16 * tq + i) * DM + h * 128 + k]; run += lg[i]; cs[i] = run; }
    tot[tq * 128 + k] = run;
    load_vt(lds, HV, rowt0, h, tid);
    __syncthreads();
    float base = 0.f, gend = 0.f;
#pragma unroll
    for (int q = 0; q < 4; ++q) { const float t = tot[q * 128 + k]; if (q < tq) base += t; gend += t; }
    LAS unsigned short* kt = (LAS unsigned short*)(lds + L_KT);
#pragma unroll
    for (int i = 0; i < 16; ++i) { const float kk = 1.f - __expf(lg[i]); kt[k * 72 + 16 * tq + i] = f2bf(kk * __expf(gend - (base + cs[i]))); }
    if (tq == 0) Dc[(size_t)unit * 128 + k] = __expf(gend);
    __syncthreads();
    const int fr = lane & 15, fq = lane >> 4;
#pragma unroll
    for (int vy = 0; vy < 8; ++vy) {
        f32x4 acc = {0.f, 0.f, 0.f, 0.f};
        acc = mma16(lds + L_KT + (16 * wave) * S144, S144, lds + L_VT + (16 * vy) * S144, S144, 2, acc, fr, fq);
        MFMA_SETTLE4(acc);
        u32x2 w; w.x = cvt_pk_bf16(acc[0], acc[1]); w.y = cvt_pk_bf16(acc[2], acc[3]);
        __hip_atomic_store((unsigned long long*)(DS + (size_t)unit * 16384 + (16 * vy + fr) * 128 + 16 * wave + 4 * fq), ((unsigned long long)w.y << 32) | w.x, __ATOMIC_RELAXED, __HIP_MEMORY_SCOPE_AGENT);
    }
    __syncthreads();
}
__device__ __forceinline__ void hg_h3_unit(LAS unsigned char* lds, const float* LG, const bf16_t* HV, bf16_t* HQ, const bf16_t* GATE, const bf16_t* DS, const float* gnorm, int unit, int tid, int wave, int lane) {
    const int n = unit >> 10, h = (unit >> 7) & 7, c = unit & 127;
    const size_t rowt0 = (size_t)n * SEQ + c * 64;
    const int k = tid & 127, tq = tid >> 7;
    LAS float* tot = (LAS float*)(lds + L_TOT);
    float lg[16], cs[16], qv[16];
    float run = 0.f;
#pragma unroll
    for (int i = 0; i < 16; ++i) { const size_t off = (rowt0 + 16 * tq + i) * DM + h * 128 + k; lg[i] = LG[off]; qv[i] = bf2f(HQ[off]); run += lg[i]; cs[i] = run; }
    tot[tq * 128 + k] = run;
#pragma unroll
    for (int e = 0; e < 4; ++e) { const int idx = tid + 512 * e, v = idx >> 4, ch = idx & 15;
        *(LAS u32x4*)(lds + L_ST + v * S272 + ch * 16) = *(const u32x4*)(DS + (size_t)unit * 16384 + v * 128 + ch * 8); }
    load_vt(lds, HV, rowt0, h, tid);
    __syncthreads();
    float bs[4]; { float a = 0.f;
#pragma unroll
        for (int q = 0; q < 4; ++q) { bs[q] = a; a += tot[q * 128 + k]; } }
    const float base = tq == 0 ? bs[0] : tq == 1 ? bs[1] : tq == 2 ? bs[2] : bs[3];
    LAS unsigned short* q0p = (LAS unsigned short*)(lds + L_Q0); LAS unsigned short* qip = (LAS unsigned short*)(lds + L_QI); LAS unsigned short* ktp = (LAS unsigned short*)(lds + L_KT);
#pragma unroll
    for (int i = 0; i < 16; ++i) {
        const int t = 16 * tq + i; const float G = base + cs[i];
        q0p[t * 136 + k] = f2bf(qv[i] * __expf(G));
        qip[t * 136 + k] = f2bf(qv[i] * __expf(cs[i]));
        const float kk = 1.f - __expf(lg[i]);
#pragma unroll
        for (int ii = 0; ii < 4; ++ii) if (ii >= tq) { const int rb = ii == 0 ? 0 : ii == 1 ? 16 : ii == 2 ? 48 : 96; ktp[(rb + t) * 136 + k] = f2bf(kk * __expf(bs[ii] - G)); }
    }
    __syncthreads();
    const int fr = lane & 15, fq = lane >> 4;
    for (int tl = wave; tl < 16; tl += 8) {
        int ti, tj;
        if (tl < 10) { ti = tl < 1 ? 0 : tl < 3 ? 1 : tl < 6 ? 2 : 3; tj = tl - (ti * (ti + 1)) / 2; }
        else { const int z = tl - 10; ti = z < 3 ? 0 : z < 5 ? 1 : 2; tj = z < 3 ? z + 1 : z < 5 ? z - 1 : 3; }
        f32x4 acc = {0.f, 0.f, 0.f, 0.f};
        if (tl < 10) {
            const int rb = ti == 0 ? 0 : ti == 1 ? 16 : ti == 2 ? 48 : 96;
            acc = mma16(lds + L_KT + (rb + 16 * tj) * S272, S272, lds + L_QI + (16 * ti) * S272, S272, 4, acc, fr, fq);
            MFMA_SETTLE4(acc);
            if (ti == tj) {
#pragma unroll
                for (int e = 0; e < 4; ++e) if (4 * fq + e > fr) acc[e] = 0.f;
            }
        }
        u32x2 w; w.x = cvt_pk_bf16(acc[0], acc[1]); w.y = cvt_pk_bf16(acc[2], acc[3]);
        *(LAS u32x2*)(lds + L_A + (16 * ti + fr) * S144 + (16 * tj + 4 * fq) * 2) = w;
    }
    const int tt = wave & 3, vh = wave >> 2;
    f32x4 oa[4];
#pragma unroll
    for (int vt = 0; vt < 4; ++vt) { oa[vt] = (f32x4){0.f, 0.f, 0.f, 0.f}; oa[vt] = mma16(lds + L_ST + (16 * (4 * vh + vt)) * S272, S272, lds + L_Q0 + (16 * tt) * S272, S272, 4, oa[vt], fr, fq); }
    __syncthreads();
    float ss = 0.f;
#pragma unroll
    for (int vt = 0; vt < 4; ++vt) oa[vt] = mma16(lds + L_VT + (16 * (4 * vh + vt)) * S144, S144, lds + L_A + (16 * tt) * S144, S144, 2, oa[vt], fr, fq);
    MFMA_SETTLE4(oa[0]); MFMA_SETTLE4(oa[1]); MFMA_SETTLE4(oa[2]); MFMA_SETTLE4(oa[3]);
#pragma unroll
    for (int vt = 0; vt < 4; ++vt) {
        ss += (oa[vt][0] * oa[vt][0] + oa[vt][1] * oa[vt][1]) + (oa[vt][2] * oa[vt][2] + oa[vt][3] * oa[vt][3]); }
    ss += __shfl_xor(ss, 16); ss += __shfl_xor(ss, 32);
    LAS float* sq = (LAS float*)(lds + L_SSQ);
    if (fq == 0) sq[vh * 64 + 16 * tt + fr] = ss;
    __syncthreads();
    const float rn = rsqrtf((sq[16 * tt + fr] + sq[64 + 16 * tt + fr]) * (1.f / 128.f) + EPS);
#pragma unroll
    for (int vt = 0; vt < 4; ++vt) {
        const int v = 16 * (4 * vh + vt) + 4 * fq; const size_t off = (rowt0 + 16 * tt + fr) * DM + h * 128 + v;
        const f32x4 gn = *(const f32x4*)(gnorm + h * 128 + v); const u32x2 gw = *(const u32x2*)(GATE + off);
        u32x2 w; w.x = cvt_pk_bf16(oa[vt][0] * rn * gn.x * bflo(gw.x), oa[vt][1] * rn * gn.y * bfhi(gw.x)); w.y = cvt_pk_bf16(oa[vt][2] * rn * gn.z * bflo(gw.y), oa[vt][3] * rn * gn.w * bfhi(gw.y));
        *(u32x2*)(HQ + off) = w;
    }
    __syncthreads();
}
__device__ __forceinline__ void hg_sample_unit(LAS unsigned char* lds, const float* S0, const float* LG, const bf16_t* HV, bf16_t* HQ, const bf16_t* GATE, const float* gnorm, float* Sout, int unit, int tid) {
    const int n = unit >> 3, h = unit & 7;
    const int v4 = (tid & 31) * 4, kg = tid >> 5;
    const size_t sbase = (size_t)unit * 16384;
    LAS float* red = (LAS float*)lds;
    LAS float* ol = (LAS float*)(lds + 32768);
    f32x4 S[8];
#pragma unroll
    for (int j = 0; j < 8; ++j) S[j] = *(const f32x4*)(S0 + sbase + (size_t)(8 * kg + j) * 128 + v4);
#pragma unroll 1
    for (int i = 0; i < 4; ++i) {
        const size_t roff = ((size_t)MP + 4 * n + i) * DM + h * 128;
        const u32x2 vw = *(const u32x2*)(HV + roff + v4);
        const f32x4 vv = {bflo(vw.x), bfhi(vw.x), bflo(vw.y), bfhi(vw.y)};
        f32x4 po = {0.f, 0.f, 0.f, 0.f};
#pragma unroll
        for (int j = 0; j < 8; ++j) {
            const float f = __expf(LG[roff + 8 * kg + j]), kk = 1.f - f, qq = bf2f(HQ[roff + 8 * kg + j]);
            S[j] = S[j] * f + vv * kk; po += S[j] * qq;
        }
        *(LAS f32x4*)(red + (i * 16 + kg) * 128 + v4) = po;
    }
#pragma unroll
    for (int j = 0; j < 8; ++j) *(f32x4*)(Sout + sbase + (size_t)(8 * kg + j) * 128 + v4) = S[j];
    __syncthreads();
    const int i = tid >> 7, v = tid & 127;
    float o = 0.f;
#pragma unroll
    for (int g = 0; g < 16; ++g) o += red[(i * 16 + g) * 128 + v];
    ol[i * 128 + v] = o;
    __syncthreads();
    float ss = 0.f;
    for (int e = 0; e < 128; e += 4) { const f32x4 x = *(const LAS f32x4*)(ol + i * 128 + e); ss += (x.x * x.x + x.y * x.y) + (x.z * x.z + x.w * x.w); }
    const float rn = rsqrtf(ss * (1.f / 128.f) + EPS);
    const size_t off = ((size_t)MP + 4 * n + i) * DM + h * 128 + v;
    HQ[off] = f2bf(o * rn * gnorm[h * 128 + v] * bf2f(GATE[off]));
    __syncthreads();
}


constexpr size_t WS_BAR = 1280 * 1024 + 8192;
#define XB_XCNT(j)  (256  + 64 * (j))
#define XB_XSUB(j)  (1280 + 64 * (j))
#define XB_XGEN(j)  (2304 + 64 * (j))
#define XB_TOP      3328
#define XB_TOPGEN   3392
constexpr int XB_BYTES = 16384;
struct GridBar { unsigned* bar; unsigned x, nloc, nx, G; };
__device__ __forceinline__ unsigned xb_ld(unsigned* p)              { return __hip_atomic_load(p, __ATOMIC_RELAXED, __HIP_MEMORY_SCOPE_AGENT); }
__device__ __forceinline__ unsigned xb_add(unsigned* p, unsigned v) { return __hip_atomic_fetch_add(p, v, __ATOMIC_RELAXED, __HIP_MEMORY_SCOPE_AGENT); }
__device__ __forceinline__ void grid_barrier_init(GridBar& b, unsigned* bar, unsigned G) {
    b.bar = bar; b.G = G; b.nloc = 0u; b.nx = 0u;
    b.x = (unsigned)__builtin_amdgcn_s_getreg((3 << 11) | 20) & 0xFu;
    if (threadIdx.x == 0) (void)xb_add(&bar[XB_XCNT(b.x)], 1u);
}
__device__ __forceinline__ void grid_barrier(GridBar& b) {
    asm volatile("s_waitcnt vmcnt(0)" ::: "memory");
    __syncthreads();
    if (threadIdx.x == 0) {
        unsigned* bar = b.bar;
        if (b.nloc == 0u) {
            for (;;) { unsigned sum = 0u, cnt = 0u, mine = 0u;
#pragma unroll
                for (unsigned j = 0; j < 16; ++j) { const unsigned c = xb_ld(&bar[XB_XCNT(j)]); sum += c; cnt += (c > 0u) ? 1u : 0u; mine = (j == b.x) ? c : mine; }
                if (sum == b.G) { b.nloc = mine; b.nx = cnt; break; }
                __builtin_amdgcn_s_sleep(1); }
        }
        const unsigned old = xb_add(&bar[XB_XSUB(b.x)], 1u), gen = old / b.nloc;
        if (old + 1u == (gen + 1u) * b.nloc) {
            __builtin_amdgcn_fence(__ATOMIC_RELEASE, "agent");
            asm volatile("s_waitcnt vmcnt(0)" ::: "memory");
            const unsigned og = xb_add(&bar[XB_TOP], 1u), tg = og / b.nx;
            if (og + 1u == (tg + 1u) * b.nx) (void)xb_add(&bar[XB_TOPGEN], 1u);
            else { while (xb_ld(&bar[XB_TOPGEN]) == tg) __builtin_amdgcn_s_sleep(1); }
            __builtin_amdgcn_fence(__ATOMIC_ACQUIRE, "agent");
            (void)xb_add(&bar[XB_XGEN(b.x)], 1u);
            asm volatile("s_waitcnt vmcnt(0)" ::: "memory");
        } else {
            while (xb_ld(&bar[XB_XGEN(b.x)]) == gen) __builtin_amdgcn_s_sleep(1);
            __builtin_amdgcn_fence(__ATOMIC_ACQUIRE, "agent");
            asm volatile("s_waitcnt vmcnt(0)" ::: "memory");
        }
    }
    __syncthreads();
}
#ifndef EN_POOL
#define EN_POOL 1
#define SKIP_SAMPLE 0
#ifndef USE_CG_SYNC
#define USE_CG_SYNC 0
#endif
#ifndef EXP_A
#define EXP_A 0
#endif
#ifndef SCAN_B
#define SCAN_B 16
#endif
#define NO_SCAN_STORE 0
#endif
#ifndef EN_ATT
#define EN_ATT 1
#endif
#ifndef EN_HG
#define EN_HG 1
#endif
#ifndef EN_GEMM
#define EN_GEMM 1
#endif
#ifndef EN_PRO
#define EN_PRO 1
#endif
#define IN(k) (LO <= (k) && (k) < HI)
#define PH_BEGIN const int tid = threadIdx.x; const int lane = tid & 63, wave = __builtin_amdgcn_readfirstlane(tid >> 6); (void)lane; (void)wave
#define SEAM(k) do { if (IN(k) && IN((k) + 1)) { grid_barrier(gbar); if (USE_CG_SYNC) grid.sync(); } } while (0)
#define GEMM_PHASE(EpiT, E, Aptr, Bptr, N_, K_, lda_, ldb_, acol_) do { if (!EN_GEMM) break; pg8::Gemm g{(const bf16_t*)(Aptr), (const bf16_t*)(Bptr), MT, (N_), (K_), (lda_), (ldb_), (acol_)}; \
        pg8::StaticOrder S; S.init(MT, (N_), G, bid); pg8::gemm_phase<EpiT, pg8::StaticOrder, true, true>(lds, g, S, E); } while (0)
#define RESID_SPLIT_GEMM(E_, APTR_, BPTR_, K_) \
            { \
                float* P = (float*)(ws + R_DS); \
                EpiDown ED{E_, EpiPartial{P}}; \
                pg8::Gemm g2{(const bf16_t*)(APTR_), (const bf16_t*)(BPTR_), MT, 1024, (K_), (K_), (K_), 0}; \
                pg8::DownOrder S2; S2.so.init(MP, 1024, 256, 0); S2.G = G; S2.c = bid; S2.S = (K_) / pg8::KSLICE; \
                if (EN_GEMM) pg8::gemm_phase<EpiDown, pg8::DownOrder, true, true>(lds, g2, S2, ED); \
                grid_barrier(gbar); \
                const int lane_ = threadIdx.x & 63, wave_ = __builtin_amdgcn_readfirstlane(threadIdx.x >> 6); \
                _Pragma("unroll 1") \
                for (int t = bid * 8 + wave_; t < MS * 4; t += G * 8) { \
                    const int r = t >> 2, qd = t & 3, row = MP + r; \
                    f32x4* xr = (f32x4*)(h + (size_t)row * DM) + qd * 64 + lane_; \
                    const float* pp = P + (size_t)((r >> 8) * 4 + qd) * 65536 + (r & 255) * 256 + 4 * lane_; \
                    f32x4 v = *xr; \
                _Pragma("unroll 8") \
                    for (int ks = 0; ks < (K_) / pg8::KSLICE; ++ks) v += *(const f32x4*)(pp + (size_t)(ks * 8) * 65536); \
                    *xr = v; \
                    u32x2 w; w.x = cvt_pk_bf16(v.x, v.y); w.y = cvt_pk_bf16(v.z, v.w); *((u32x2*)(hb + (size_t)row * DM) + qd * 64 + lane_) = w; \
                    const float sq = wave_sum((v.x * v.x + v.y * v.y) + (v.z * v.z + v.w * v.w)); \
                    if (lane_ == 0) ssq[(size_t)row * 16 + qd] = sq; \
                    else if (lane_ < 4) ssq[(size_t)row * 16 + 4 + qd * 3 + (lane_ - 1)] = 0.f; \
                } \
            }
template <int LO, int HI, int LAYER>
__device__ __forceinline__ void layer_phases(const Args& args, cg::grid_group& grid, GridBar& gbar, LAS unsigned char* lds, int G, int bid) {
    unsigned char* ws = args.ws; float* out = args.out;
    float* ssq = (float*)(ws + WS_SSQ); float* lbuf = (float*)(ws + WS_LB); float* rope = (float*)(ws + WS_ROPE); float* Dc = (float*)(ws + WS_DC);
    bf16_t* hb = (bf16_t*)(ws + WS_HB); float* h = out + O_Y;
    const float* xp = args.in[0]; const float* xs = args.in[1];
    const float* norm_mix = args.in[6];
        constexpr int layer = LAYER; constexpr int pb = layer * 7 + 1;
        constexpr int kind = layer % 3;
        const float* src_p = layer == 0 ? xp : h; const float* src_s = layer == 0 ? xs : h + (size_t)MP * DM;
        if constexpr (kind == 0) {
            constexpr int ip = layer / 3;
            if (IN(pb) && EN_POOL) {
                PH_BEGIN;
                LAS float* rl = (LAS float*)lds;
                bf16_t* dbuf = (bf16_t*)(ws + R_D);
                for (int u = bid; u < 256 + 128; u += G) {
                    if (u < 256) pool_unit<false>(src_p, src_s, norm_mix + layer * DM, nullptr, dbuf, out + O_POOLP + (size_t)ip * 2 * 15 * 1024, u, rl, tid, wave, lane);
                    else pool_unit<true>(src_p, src_s, norm_mix + layer * DM, args.in[2] + (size_t)ip * 128 * 15 * 1024, dbuf, out + O_POOLS + (size_t)ip * 128 * 15 * 1024, u - 256, rl, tid, wave, lane);
                }
            }
            SEAM(pb);
            if (IN(pb + 1)) {
                EpiResid E{src_p, src_s, h, hb, ssq, args.in[10] + ip * DM};
                GEMM_PHASE(EpiResid, E, ws + R_D, ws + (ip == 0 ? W_POOL0 : W_POOL1), 1024, 256, 1024, 256, 256);
            }
            SEAM(pb + 1);
        } else if constexpr (kind == 1) {
            if (IN(pb)) {
                EpiQKV E{(bf16_t*)(ws + R_Q), (bf16_t*)(ws + R_K), (bf16_t*)(ws + R_V), ssq, rope, out + O_KP, out + O_KS, out + O_VP, out + O_VS};
                GEMM_PHASE(EpiQKV, E, hb, ws + W_QKV, 1536, 1024, 1024, 1024, 0);
                const int extra = 396 > G ? 396 - G : 0;
                if (bid >= extra) {
                    const int gt = (bid - extra) * 512 + (int)threadIdx.x, NT = (G - extra) * 512;
                    for (int e = gt; e < 128 * 124 * 64; e += NT) { const int n = e / (124 * 64), rem = e % (124 * 64);
                        const size_t so = (size_t)n * 128 * 256 + 4 * 256 + (size_t)rem * 4, dd = (size_t)n * 128 * 256 + (size_t)rem * 4;
                        *(f32x4*)(out + O_KS + dd) = *(const f32x4*)(args.in[3] + so); *(f32x4*)(out + O_VS + dd) = *(const f32x4*)(args.in[4] + so); }
                }
            }
            SEAM(pb);
            if (IN(pb + 1) && EN_ATT) {
                PH_BEGIN;
                const bf16_t* Qb = (const bf16_t*)(ws + R_Q); const bf16_t* Kb = (const bf16_t*)(ws + R_K); const bf16_t* Vb = (const bf16_t*)(ws + R_V); bf16_t* Ob = (bf16_t*)(ws + R_O);
                for (int u = bid; u < 1024; u += G) attn_prompt_unit(Qb, Kb, Vb, Ob, args.in[15], u, wave, lane);
                for (int u = bid; u < 256; u += G) { const int wu = u * 8 + wave; attn_sample_wave(wu >> 4, wu & 15, Qb, Kb, Vb, args.in[3], args.in[4], Ob, args.in[15], (LAS float*)(lds + wave * 4096), lane); }
            }
            SEAM(pb + 1);
        } else {
            if (IN(pb)) {
                EpiHg E{(float*)(ws + R_LG), (bf16_t*)(ws + R_HV), (bf16_t*)(ws + R_HQ), (bf16_t*)(ws + WS_GATE), ssq, lbuf};
                GEMM_PHASE(EpiHg, E, hb, ws + W_HG, 4096, 1024, 1024, 1024, 0);
            }
            SEAM(pb);
            if ((IN(pb + 1) || IN(pb + 2) || IN(pb + 3)) && EN_HG) {
                const float* LG = (const float*)(ws + R_LG); const bf16_t* HV = (const bf16_t*)(ws + R_HV); bf16_t* HQ = (bf16_t*)(ws + R_HQ); const bf16_t* GATE = (const bf16_t*)(ws + WS_GATE); bf16_t* DS = (bf16_t*)(ws + R_DS);
                if (IN(pb + 1)) { PH_BEGIN; for (int u = bid; u < 2048; u += G) hg_h1_unit(lds, LG, HV, DS, Dc, u, tid, wave, lane); }
                SEAM(pb + 1);
                if (IN(pb + 2)) {
                PH_BEGIN;
                for (int gidx = bid * 512 + tid; gidx < 16 * 8192; gidx += G * 512) {
                    const int chain = gidx >> 13, e = (gidx & 8191) * 2, k = e & 127, v = e >> 7;
                    float s0 = 0.f, s1 = 0.f;
                    unsigned* dsp = (unsigned*)(DS + (size_t)chain * 128 * 16384 + e); const float* dcp = Dc + (size_t)chain * 128 * 128 + k;
                    for (int c0 = 0; c0 < 128; c0 += SCAN_B) {
                        unsigned dw[SCAN_B]; f32x2 dv[SCAN_B];
#pragma unroll
                        for (int j = 0; j < SCAN_B; ++j) { dw[j] = dsp[(size_t)(c0 + j) * 8192]; dv[j] = *(const f32x2*)(dcp + (size_t)(c0 + j) * 128); }
                        asm volatile("s_waitcnt vmcnt(0)" ::: "memory");
#pragma unroll
                        for (int j = 0; j < SCAN_B; ++j) { if (!NO_SCAN_STORE) dsp[(size_t)(c0 + j) * 8192] = cvt_pk_bf16(s0, s1); s0 = dv[j].x * s0 + bflo(dw[j]); s1 = dv[j].y * s1 + bfhi(dw[j]); }
                    }
                    float* o = out + O_HP + (size_t)chain * 16384; o[(size_t)k * 128 + v] = s0; o[(size_t)(k + 1) * 128 + v] = s1;
                }
                if (!SKIP_SAMPLE) for (int u = bid; u < 1024; u += G) hg_sample_unit(lds, args.in[5], LG, HV, HQ, GATE, args.in[22], out + O_HS, u, tid);
                }
                SEAM(pb + 2);
                if (IN(pb + 3)) { PH_BEGIN; for (int u = bid; u < 2048; u += G) hg_h3_unit(lds, LG, HV, HQ, GATE, DS, args.in[22], u, tid, wave, lane); }
                SEAM(pb + 3);
            }
        }
        if constexpr (kind != 0) {
            constexpr int ps = kind == 1 ? pb + 2 : pb + 4;
            if (IN(ps)) {
                EpiResid E{src_p, src_s, h, hb, ssq, nullptr};
                if constexpr (kind == 1) GEMM_PHASE(EpiResid, E, ws + R_O, ws + W_SWO, 1024, 1024, 1024, 1024, 0);
                else { RESID_SPLIT_GEMM(E, ws + R_HQ, ws + W_HGO, 1024); }
            }
            SEAM(ps);
        }
        const size_t wup = layer == 0 ? W_UP0 : layer == 1 ? W_UP1 : layer == 2 ? W_UP2 : W_UP3, wdn = layer == 0 ? W_DN0 : layer == 1 ? W_DN1 : layer == 2 ? W_DN2 : W_DN3;
        if (IN(pb + 5)) {
            EpiFfnUp E{(bf16_t*)(ws + R_HID), ssq};
            GEMM_PHASE(EpiFfnUp, E, hb, ws + wup, 4096, 1024, 1024, 1024, 0);
        }
        SEAM(pb + 5);
        if (IN(pb + 6) && !(EXP_A && (HI - LO) > 1)) {
            EpiResid E{h, h + (size_t)MP * DM, h, hb, ssq, nullptr};
            RESID_SPLIT_GEMM(E, ws + R_HID, ws + wdn, 4096);
        }
        SEAM(pb + 6);
    }
template <int LO, int HI>
__global__ void __launch_bounds__(512, 2) mega_fwd(Args args) {
    extern __shared__ __attribute__((aligned(16))) unsigned char lds_raw[];
    LAS unsigned char* lds = (LAS unsigned char*)lds_raw;
    cg::grid_group grid = cg::this_grid();
    const int G = gridDim.x, bid = blockIdx.x;
    GridBar gbar; grid_barrier_init(gbar, (unsigned*)(args.ws + WS_BAR), (unsigned)gridDim.x);
    if (HI - LO > 1 && gridDim.y == 0x7fffu) grid.sync();
    unsigned char* ws = args.ws; float* out = args.out;
    float* ssq = (float*)(ws + WS_SSQ); float* lbuf = (float*)(ws + WS_LB); float* rope = (float*)(ws + WS_ROPE); float* Dc = (float*)(ws + WS_DC);
    bf16_t* hb = (bf16_t*)(ws + WS_HB); float* h = out + O_Y;
    const float* xp = args.in[0]; const float* xs = args.in[1];
    const float* norm_mix = args.in[6]; const float* norm_ffn = args.in[7];

    if (IN(0) && EN_PRO) {
        PH_BEGIN;
        LAS float* scr = (LAS float*)(lds + wave * 16384);
        const int gw = bid * 8 + wave, NGW = G * 8;
        for (int it = gw; it < 20480; it += NGW) {
            int r = it;
#define TI(cnt, W, K, N, gain, dst, ldk, roff) if (r < (cnt)) { transpose_item((W), (K), (N), (gain), (bf16_t*)(ws + (dst)), (ldk), (roff), scr, r, lane); continue; } r -= (cnt);
            TI(2048, args.in[23] + (size_t)0 * DM * FF, DM, FF, norm_ffn + 0 * DM, W_UP0, DM, 0)
            TI(2048, args.in[23] + (size_t)1 * DM * FF, DM, FF, norm_ffn + 1 * DM, W_UP1, DM, 0)
            TI(2048, args.in[23] + (size_t)2 * DM * FF, DM, FF, norm_ffn + 2 * DM, W_UP2, DM, 0)
            TI(2048, args.in[23] + (size_t)3 * DM * FF, DM, FF, norm_ffn + 3 * DM, W_UP3, DM, 0)
            TI(2048, args.in[24] + (size_t)0 * DM * FF, FF, DM, nullptr, W_DN0, FF, 0)
            TI(2048, args.in[24] + (size_t)1 * DM * FF, FF, DM, nullptr, W_DN1, FF, 0)
            TI(2048, args.in[24] + (size_t)2 * DM * FF, FF, DM, nullptr, W_DN2, FF, 0)
            TI(2048, args.in[24] + (size_t)3 * DM * FF, FF, DM, nullptr, W_DN3, FF, 0)
            TI(512, args.in[11], DM, 1024, norm_mix + 1 * DM, W_QKV, DM, 0)
            TI(128, args.in[12], DM, 256, norm_mix + 1 * DM, W_QKV, DM, 1024)
            TI(128, args.in[13], DM, 256, norm_mix + 1 * DM, W_QKV, DM, 1280)
            TI(512, args.in[14], DM, 1024, nullptr, W_SWO, DM, 0)
            TI(512, args.in[17], DM, 1024, norm_mix + 2 * DM, W_HG, DM, 0)
            TI(512, args.in[18], DM, 1024, norm_mix + 2 * DM, W_HG, DM, 1024)
            TI(512, args.in[19], DM, 1024, norm_mix + 2 * DM, W_HG, DM, 2048)
            TI(512, args.in[20], DM, 1024, norm_mix + 2 * DM, W_HG, DM, 3072)
            TI(512, args.in[21], DM, 1024, nullptr, W_HGO, DM, 0)
            { const int pi = r >> 5; r &= 31;
              transpose_item(args.in[9] + (size_t)pi * 65536, 256, 256, nullptr, (bf16_t*)(ws + (pi < 4 ? W_POOL0 : W_POOL1)), 256, (pi & 3) * 256, scr, r, lane); }
#undef TI
        }
        const int gt = bid * 512 + tid, NT = G * 512;
        for (int c = gt; c < 1024; c += NT) {
            const float* p = args.in[16] + c; const float a0 = p[0], a1 = p[1024], a2 = p[2048], a3 = p[3072];
            const float mx = fmaxf(fmaxf(a0, a1), fmaxf(a2, a3)); const float e0 = expf(a0 - mx), e1 = expf(a1 - mx), e2 = expf(a2 - mx), e3 = expf(a3 - mx);
            lbuf[c] = (e1 + e2) / (e0 + e1 + e2 + e3);
        }
        for (int e = gt; e < 8196 * 8; e += NT) {
            const int pos = e >> 3, j = e & 7; const float inv = powf(500000.0f, -(float)j * 0.125f); const float ang = (float)pos * inv;
            rope[(size_t)pos * 16 + 2 * j] = cosf(ang); rope[(size_t)pos * 16 + 2 * j + 1] = sinf(ang);
        }
    }
    if (IN(0) && IN(1)) __syncthreads();


    layer_phases<LO, HI, 0>(args, grid, gbar, lds, G, bid);
    layer_phases<LO, HI, 1>(args, grid, gbar, lds, G, bid);
    layer_phases<LO, HI, 2>(args, grid, gbar, lds, G, bid);
    layer_phases<LO, HI, 3>(args, grid, gbar, lds, G, bid);
    if (IN(29)) {
        PH_BEGIN;
        const float* gf = args.in[8];
        for (int row = bid * 8 + wave; row < MT; row += G * 8) {
            f32x4* xr = (f32x4*)(h + (size_t)row * DM) + lane; f32x4 v[4]; float s = 0.f;
#pragma unroll
            for (int j = 0; j < 4; ++j) { v[j] = xr[64 * j]; s += (v[j].x * v[j].x + v[j].y * v[j].y) + (v[j].z * v[j].z + v[j].w * v[j].w); }
            const float r = rsqrtf(wave_sum(s) * (1.f / 1024.f) + EPS);
#pragma unroll
            for (int j = 0; j < 4; ++j) xr[64 * j] = v[j] * r * *((const f32x4*)gf + lane + 64 * j);
        }
    }
#undef IN
#undef SEAM
#undef GEMM_PHASE
}

#define HI_LIMIT 30
#ifndef N_LAUNCH_MODE
#define MERGE_LO 0
#define MERGE_HI 22
#define PLAN(X) X(0, 30)
#define N_LAUNCH_MODE 3
#endif
template <int LO, int HI> static void launch_range(int grid, Args& a, hipStream_t stream) {
    void* kargs[] = {&a};
    hipError_t e = hipLaunchCooperativeKernel((const void*)mega_fwd<LO, HI>, dim3(grid), dim3(512), kargs, LDS_BYTES, stream);
    if (e != hipSuccess) fprintf(stderr, "cooperative launch <%d,%d> failed: %s (grid %d)\n", LO, HI, hipGetErrorString(e), grid);
}
template <int LO, int HI> static void prep_range() { (void)hipFuncSetAttribute((const void*)mega_fwd<LO, HI>, hipFuncAttributeMaxDynamicSharedMemorySize, LDS_BYTES); }
#define FOR_PHASES(X) X(0) X(1) X(2) X(6) X(7) X(8) X(9) X(10) X(13) X(14) X(15) X(16) X(17) X(18) X(19) X(20) X(21) X(22) X(23) X(27) X(28) X(29)
extern "C" void kernel_launch(void* const* d_in, const int* in_sizes, int n_in, void* d_out, int out_size, void* d_ws, size_t ws_size, hipStream_t stream) {
    static int grid = 0;
    if (grid == 0) {
        if (n_in != 25 || ws_size < WS_END) { fprintf(stderr, "kernel_launch: bad shapes: n_in %d ws %zu (need %zu)\n", n_in, ws_size, (size_t)WS_END); grid = -1; return; }
        int dev = 0, cus = 0, per_cu = 0;
        (void)hipGetDevice(&dev); (void)hipDeviceGetAttribute(&cus, hipDeviceAttributeMultiprocessorCount, dev);
#if N_LAUNCH_MODE == 1
        prep_range<0, 30>();
        (void)hipOccupancyMaxActiveBlocksPerMultiprocessor(&per_cu, (const void*)mega_fwd<0, 30>, 512, LDS_BYTES);
#elif N_LAUNCH_MODE == 3
#define PREP_R(a, b) prep_range<a, b>();
        PLAN(PREP_R)
        per_cu = 1;
#elif N_LAUNCH_MODE == 2
        prep_range<MERGE_LO, MERGE_HI>();
#define PREP(k) prep_range<k, k + 1>();
        FOR_PHASES(PREP)
        per_cu = 1;
#else
#define PREP(k) prep_range<k, k + 1>();
        FOR_PHASES(PREP)
        per_cu = 1;
#endif
        if (per_cu < 1) per_cu = 1;
        grid = cus * per_cu;
        (void)hipGetLastError();
    }
    if (grid < 0) return;
    (void)hipMemsetAsync((char*)d_ws + WS_BAR, 0, XB_BYTES, stream);
    Args a{};
    for (int i = 0; i < 25; ++i) a.in[i] = (const float*)d_in[i];
    a.out = (float*)d_out; a.ws = (unsigned char*)d_ws;
    Args& args_ = a; (void)args_;
#if N_LAUNCH_MODE == 1
    launch_range<0, 30>(grid, a, stream);
#elif N_LAUNCH_MODE == 3
#define LAUNCH_R(a, b) launch_range<a, b>(grid, args_, stream);
    PLAN(LAUNCH_R)
#elif N_LAUNCH_MODE == 2
#define LAUNCH_A(k) if ((k) < MERGE_LO) launch_range<k, k + 1>(grid, a, stream);
    FOR_PHASES(LAUNCH_A)
    launch_range<MERGE_LO, MERGE_HI>(grid, a, stream);
    if (EXP_A) launch_range<7, 8>(grid, a, stream);
#define LAUNCH_B(k) if ((k) >= MERGE_HI) launch_range<k, k + 1>(grid, a, stream);
    FOR_PHASES(LAUNCH_B)
#else
#ifndef HI_LIMIT
#define HI_LIMIT 30
#endif
#define LAUNCH(k) if ((k) < HI_LIMIT) launch_range<k, k + 1>(grid, a, stream);
    FOR_PHASES(LAUNCH)
#endif
}
```

```cpp
#include <hip/hip_runtime.h>
#include <hip/hip_cooperative_groups.h>
#include <cstdio>
#include <cstdint>
#include <cmath>
namespace cg = cooperative_groups;

#define LAS __attribute__((address_space(3)))
typedef unsigned short bf16_t;
typedef short bf16x8 __attribute__((ext_vector_type(8)));
typedef float f32x4 __attribute__((ext_vector_type(4)));
typedef float f32x2 __attribute__((ext_vector_type(2)));
typedef float f32x16 __attribute__((ext_vector_type(16)));
typedef unsigned u32x4 __attribute__((ext_vector_type(4)));
typedef unsigned u32x2 __attribute__((ext_vector_type(2)));

#define MFMA_SETTLE4(a) asm volatile("s_nop 15\n\ts_nop 7" : "+v"(a))
#define MFMA_SETTLE16(a) asm volatile("s_nop 15\n\ts_nop 15" : "+v"(a))
constexpr int DM = 1024, FF = 4096, MP = 16384, MS = 512, MT = MP + MS, SEQ = 8192;
constexpr float EPS = 1e-6f;

typedef __bf16 bf16x2_t __attribute__((ext_vector_type(2)));
__device__ __forceinline__ unsigned cvt_pk_bf16(float lo, float hi) { f32x2 v = {lo, hi}; bf16x2_t b = __builtin_convertvector(v, bf16x2_t); return __builtin_bit_cast(unsigned, b); }
__device__ __forceinline__ void store16_sc1(void* p, u32x4 v) { asm volatile("global_store_dwordx4 %0, %1, off sc1" :: "v"(p), "v"(v) : "memory"); }
__device__ __forceinline__ float bf2f(unsigned short u) { return __uint_as_float(((unsigned)u) << 16); }
__device__ __forceinline__ float bflo(unsigned w) { return __uint_as_float(w << 16); }
__device__ __forceinline__ float bfhi(unsigned w) { return __uint_as_float(w & 0xffff0000u); }
__device__ __forceinline__ unsigned short f2bf(float f) { return (unsigned short)(cvt_pk_bf16(f, 0.f) & 0xffffu); }
__device__ __forceinline__ float wave_sum(float v) {
#pragma unroll
    for (int o = 1; o < 64; o <<= 1) v += __shfl_xor(v, o);
    return v;
}
__device__ __forceinline__ float wave_max(float v) {
#pragma unroll
    for (int o = 1; o < 64; o <<= 1) v = fmaxf(v, __shfl_xor(v, o));
    return v;
}

namespace pg8 {
#define PG8_LAS __attribute__((address_space(3)))
constexpr int BM = 256, BK = 64, HALF = 128, HTB = HALF * BK * 2  , STAGE_BYTES = 8 * HTB, NXCD = 8, WGM = 8;

__host__ __device__ __forceinline__ int lds_byte(int r, int c) { const int st = (r >> 4) * 2 + (c >> 5), rr = r & 15, cc = c & 31, ob = rr * 64 + cc * 2; return st * 1024 + (ob ^ (((ob >> 9) & 1) << 5)); }
__host__ __device__ __forceinline__ void stage_rc(int b, int& R, int& C) { const int st = b / 1024, sb = b % 1024, swz = sb ^ (((sb >> 9) & 1) << 5); R = (st >> 1) * 16 + swz / 64; C = (st & 1) * 32 + (swz % 64) / 2; }
__host__ __device__ __forceinline__ int perm32(int rho) { const int n = rho >> 4, i = rho & 15; return 8 * (i >> 2) + 4 * n + (i & 3); }

struct Unit { int pm, pn, ks, nt; };
struct Gemm { const bf16_t* A; const bf16_t* Bt; int M, N, K, lda, ldb, acol; };

struct StaticOrder {
    int nM, nN, nwg, G, c;
    __host__ __device__ void init(int M, int N, int G_, int c_) { nM = M / BM; nN = N / BM; nwg = nM * nN; G = G_; c = c_; }
    __host__ __device__ bool next(int i, Unit& u) const {
        const long L = (long)i * G + c; if (L >= nwg) return false;
        int wgid = (int)L; { const int q = nwg / NXCD, r = nwg % NXCD, xcd = wgid % NXCD, off = wgid / NXCD; wgid = (xcd < r ? xcd * (q + 1) : r * (q + 1) + (xcd - r) * q) + off; }
        const int nig = WGM * nN, gid = wgid / nig, fm = gid * WGM, gsz = (nM - fm) < WGM ? (nM - fm) : WGM;
        u.pm = fm + ((wgid % nig) % gsz); u.pn = (wgid % nig) / gsz; u.ks = 0; u.nt = 0; return true;
    }
    __device__ __forceinline__ void a_ready(const Unit&) const {}
    __device__ __forceinline__ void done(const Unit&) const {}
};
constexpr int KSLICE = 256;
struct DownOrder {
    StaticOrder so; int G, c, S;
    __host__ __device__ bool next(int i, Unit& u) const {
        const int L = i * G + c;
        if (L < 256) { StaticOrder t = so; t.G = 256; t.c = L; return t.next(0, u); }
        const int q = L - 256; if (q >= 8 * S) return false;
        u.ks = q >> 3; u.pm = 64 + ((q >> 2) & 1); u.pn = q & 3; u.nt = KSLICE / BK; return true;
    }
    __device__ __forceinline__ void a_ready(const Unit&) const {}
    __device__ __forceinline__ void done(const Unit&) const {}
};
template <class Epi, class Sched, bool ALIGN_EPI = false, bool SP2 = false>
__device__ __forceinline__ void gemm_phase(PG8_LAS unsigned char* lds, const Gemm g, const Sched& S, const Epi& E) {
    int tid_l = threadIdx.x; asm volatile("" : "+v"(tid_l));
    const int tid = tid_l, wid = __builtin_amdgcn_readfirstlane(tid >> 6), lane = tid & 63, wr = wid >> 2, wc = wid & 3, fr = lane & 15, fq = lane >> 4;
    const int K = g.K; int nt = K / BK;
    unsigned voffA[2], voffB[2];
#pragma unroll
    for (int i = 0; i < 2; ++i) { int R, C; stage_rc(tid * 16 + i * 8192, R, C); const int Rb = Epi::PERM ? ((R & ~31) + perm32(R & 31)) : R;
        voffA[i] = (unsigned)(R * g.lda + C) * 2u; voffB[i] = (unsigned)(Rb * g.ldb + C) * 2u; }
    const size_t kstep = (size_t)(BK * 2);
    const size_t hstepA = (size_t)HALF * g.lda * 2, hstepB = (size_t)HALF * g.ldb * 2;
    const size_t tstepA = 2 * hstepA, tstepB = 2 * hstepB, acolb = (size_t)g.acol * 2;
    const unsigned ldsw = (unsigned)wid * 1024u;
    const int aoff = lds_byte(wr * 64 + fr, fq * 8), boff = lds_byte(wc * 32 + fr, fq * 8);
#define PG8_SA(b, h) (((b) * 2 + (h)) * HTB)
#define PG8_SB(b, h) ((4 + (b) * 2 + (h)) * HTB)
#define PG8_STAGE(bufoff, gbase, voff) do { _Pragma("unroll") for (int _i = 0; _i < 2; ++_i) \
        __builtin_amdgcn_global_load_lds((const unsigned*)((const char*)(gbase) + (voff)[_i]), (PG8_LAS unsigned*)(lds + (bufoff) + ldsw + _i * 8192), 16, 0, 0); } while (0)
#define PG8_LDA(dst, b, h) do { _Pragma("unroll") for (int m = 0; m < 4; ++m) _Pragma("unroll") for (int k = 0; k < 2; ++k) dst[m][k] = *(const PG8_LAS bf16x8*)(lds + PG8_SA(b, h) + aoff + m * 2048 + k * 1024); } while (0)
#define PG8_LDB(dst, b, h) do { _Pragma("unroll") for (int n = 0; n < 2; ++n) _Pragma("unroll") for (int k = 0; k < 2; ++k) dst[n][k] = *(const PG8_LAS bf16x8*)(lds + PG8_SB(b, h) + boff + n * 2048 + k * 1024); } while (0)
#define PG8_MMA(ai, bj, At, Bt) do { __builtin_amdgcn_s_setprio(1); _Pragma("unroll") for (int m = 0; m < 4; ++m) _Pragma("unroll") for (int n = 0; n < 2; ++n) _Pragma("unroll") for (int k = 0; k < 2; ++k) \
        acc[ai][bj][m][n] = __builtin_amdgcn_mfma_f32_16x16x32_bf16(Bt[n][k], At[m][k], acc[ai][bj][m][n], 0, 0, 0); __builtin_amdgcn_s_setprio(0); } while (0)
#define PG8_WAIT_V(n) asm volatile("s_waitcnt vmcnt(" #n ")" ::: "memory")
#define PG8_WAIT_L(n) asm volatile("s_waitcnt lgkmcnt(" #n ")" ::: "memory")
#define PG8_BAR __builtin_amdgcn_s_barrier()
#define PG8_SCHED __builtin_amdgcn_sched_barrier(0)
    Unit cur, nxt; int ui = 0;
    if (!S.next(0, cur)) return;
    f32x4 acc[2][2][4][2];
#pragma unroll
    for (int a = 0; a < 2; ++a)
#pragma unroll
        for (int b = 0; b < 2; ++b)
#pragma unroll
            for (int m = 0; m < 4; ++m)
#pragma unroll
                for (int n = 0; n < 2; ++n) acc[a][b][m][n] = (f32x4){0.f, 0.f, 0.f, 0.f};
    bf16x8 At[4][2], B0[2][2], B1[2][2];
    if (cur.nt) nt = cur.nt;
    const size_t ksb = (size_t)KSLICE * 2;
    const char* cA = (const char*)g.A + (size_t)cur.pm * tstepA + (size_t)cur.pn * acolb + (size_t)cur.ks * ksb; const char* cB = (const char*)g.Bt + (size_t)cur.pn * tstepB + (size_t)cur.ks * ksb;
    S.a_ready(cur);
    if constexpr (SP2) {
        PG8_STAGE(PG8_SB(0, 0), cB, voffB); PG8_STAGE(PG8_SB(0, 1), cB + hstepB, voffB); PG8_STAGE(PG8_SA(0, 0), cA, voffA); PG8_STAGE(PG8_SA(0, 1), cA + hstepA, voffA);
        if (wr == 1) PG8_BAR;
        PG8_WAIT_V(2); PG8_BAR;
        PG8_STAGE(PG8_SB(1, 0), cB + kstep, voffB); PG8_STAGE(PG8_SA(1, 0), cA + kstep, voffA); PG8_STAGE(PG8_SB(1, 1), cB + hstepB + kstep, voffB);
        PG8_WAIT_V(6); PG8_BAR;
    } else {
        PG8_STAGE(PG8_SB(0, 0), cB, voffB); PG8_STAGE(PG8_SA(0, 0), cA, voffA); PG8_STAGE(PG8_SB(0, 1), cB + hstepB, voffB); PG8_STAGE(PG8_SA(0, 1), cA + hstepA, voffA);
        if (wr == 1) PG8_BAR;
        PG8_WAIT_V(4); PG8_BAR;
        PG8_STAGE(PG8_SB(1, 0), cB + kstep, voffB); PG8_STAGE(PG8_SA(1, 0), cA + kstep, voffA); PG8_STAGE(PG8_SB(1, 1), cB + hstepB + kstep, voffB);
        PG8_WAIT_V(6); PG8_BAR;
    }
    for (;;) {
        const bool has_next = S.next(ui + 1, nxt);
        const char* nA = has_next ? (const char*)g.A + (size_t)nxt.pm * tstepA + (size_t)nxt.pn * acolb + (size_t)nxt.ks * ksb : cA; const char* nB = has_next ? (const char*)g.Bt + (size_t)nxt.pn * tstepB + (size_t)nxt.ks * ksb : cB;
        for (int t = 0; t < nt; t += 2) {
            const bool last = (t == nt - 2);
            const char* a1 = cA + (size_t)(t + 1) * kstep;
            const char* a2 = last ? nA : cA + (size_t)(t + 2) * kstep; const char* b2 = last ? nB : cB + (size_t)(t + 2) * kstep;
            const char* a3 = a2 + kstep; const char* b3 = b2 + kstep;
            if (last && has_next) S.a_ready(nxt);
            if constexpr (SP2) {
            PG8_LDB(B0, 0, 0); PG8_LDB(B1, 0, 1); PG8_SCHED; PG8_LDA(At, 0, 0); PG8_STAGE(PG8_SA(1, 1), a1 + hstepA, voffA);
            PG8_WAIT_V(8); PG8_WAIT_L(0); PG8_BAR; PG8_MMA(0, 0, At, B0); PG8_MMA(0, 1, At, B1); PG8_BAR; PG8_SCHED;
            PG8_LDA(At, 0, 1); PG8_STAGE(PG8_SB(0, 0), b2, voffB); PG8_STAGE(PG8_SB(0, 1), b2 + hstepB, voffB); PG8_STAGE(PG8_SA(0, 0), a2, voffA);
            PG8_WAIT_V(8); PG8_WAIT_L(0); PG8_BAR; PG8_MMA(1, 0, At, B0); PG8_MMA(1, 1, At, B1); PG8_BAR; PG8_SCHED;
            PG8_LDB(B0, 1, 0); PG8_LDB(B1, 1, 1); PG8_SCHED; PG8_LDA(At, 1, 0); PG8_STAGE(PG8_SA(0, 1), a2 + hstepA, voffA);
            PG8_WAIT_V(8); PG8_WAIT_L(0); PG8_BAR; PG8_MMA(0, 0, At, B0); PG8_MMA(0, 1, At, B1); PG8_BAR; PG8_SCHED;
            PG8_LDA(At, 1, 1); PG8_STAGE(PG8_SB(1, 0), b3, voffB); PG8_STAGE(PG8_SB(1, 1), b3 + hstepB, voffB); PG8_STAGE(PG8_SA(1, 0), a3, voffA);
            PG8_WAIT_V(8); PG8_WAIT_L(0); PG8_BAR; PG8_MMA(1, 0, At, B0); PG8_MMA(1, 1, At, B1); PG8_BAR; PG8_SCHED;
            } else {
            PG8_LDB(B0, 0, 0); PG8_SCHED; PG8_LDA(At, 0, 0); PG8_STAGE(PG8_SA(1, 1), a1 + hstepA, voffA);
            PG8_WAIT_L(8); PG8_BAR; PG8_WAIT_L(0); PG8_MMA(0, 0, At, B0); PG8_BAR; PG8_SCHED;
            PG8_LDB(B1, 0, 1); PG8_STAGE(PG8_SB(0, 0), b2, voffB);
            PG8_BAR; PG8_WAIT_L(0); PG8_MMA(0, 1, At, B1); PG8_BAR;
            PG8_LDA(At, 0, 1); PG8_STAGE(PG8_SA(0, 0), a2, voffA);
            PG8_BAR; PG8_WAIT_L(0); PG8_MMA(1, 0, At, B0); PG8_BAR; PG8_SCHED;
            PG8_STAGE(PG8_SB(0, 1), b2 + hstepB, voffB);
            PG8_WAIT_V(6); PG8_BAR; PG8_MMA(1, 1, At, B1); PG8_BAR;
            PG8_LDB(B0, 1, 0); PG8_SCHED; PG8_LDA(At, 1, 0); PG8_STAGE(PG8_SA(0, 1), a2 + hstepA, voffA);
            PG8_WAIT_L(8); PG8_BAR; PG8_WAIT_L(0); PG8_MMA(0, 0, At, B0); PG8_BAR; PG8_SCHED;
            PG8_LDB(B1, 1, 1); PG8_STAGE(PG8_SB(1, 0), b3, voffB);
            PG8_BAR; PG8_WAIT_L(0); PG8_MMA(0, 1, At, B1); PG8_BAR;
            PG8_LDA(At, 1, 1); PG8_STAGE(PG8_SA(1, 0), a3, voffA);
            PG8_BAR; PG8_WAIT_L(0); PG8_MMA(1, 0, At, B0); PG8_BAR; PG8_SCHED;
            PG8_STAGE(PG8_SB(1, 1), b3 + hstepB, voffB);
            PG8_WAIT_V(6); PG8_BAR; PG8_MMA(1, 1, At, B1); PG8_BAR;
            }
        }
        if constexpr (ALIGN_EPI) { if (wr == 0) PG8_BAR; }
        if constexpr (!Epi::AFTER_DRAIN) { E(acc, cur, wr, wc, fr, fq); S.done(cur); }
        if (!has_next) break;
#pragma unroll
        for (int a = 0; a < 2; ++a)
#pragma unroll
            for (int b = 0; b < 2; ++b)
#pragma unroll
                for (int m = 0; m < 4; ++m)
#pragma unroll
                    for (int n = 0; n < 2; ++n) acc[a][b][m][n] = (f32x4){0.f, 0.f, 0.f, 0.f};
        cur = nxt; cA = nA; cB = nB; ++ui; nt = cur.nt ? cur.nt : K / BK;
        if constexpr (ALIGN_EPI) { if (wr == 1) PG8_BAR; }
    }
    PG8_WAIT_V(0);
    if constexpr (!ALIGN_EPI) { if (wr == 0) PG8_BAR; }
    PG8_BAR;
    if constexpr (Epi::AFTER_DRAIN) { E.fused(acc, cur, wr, wc, fr, fq, lds, wid, lane); S.done(cur); }
#undef PG8_SA
#undef PG8_SB
#undef PG8_STAGE
#undef PG8_LDA
#undef PG8_LDB
#undef PG8_MMA
#undef PG8_WAIT_V
#undef PG8_WAIT_L
#undef PG8_BAR
#undef PG8_SCHED
}
}

using pg8::Unit;
constexpr size_t MiB = 1u << 20;
constexpr size_t WS_SSQ = 0;
constexpr size_t WS_LB = 1280 * 1024;
constexpr size_t WS_ROPE = 1536 * 1024;
constexpr size_t WS_DC = 2560 * 1024;
constexpr size_t WS_W = 4 * MiB;
constexpr size_t W_UP0 = WS_W, W_DN0 = W_UP0 + 8 * MiB, W_UP1 = W_DN0 + 8 * MiB, W_DN1 = W_UP1 + 8 * MiB;
constexpr size_t W_QKV = W_DN1 + 8 * MiB, W_SWO = W_QKV + 3 * MiB, W_POOL0 = W_SWO + 2 * MiB;
constexpr size_t WS_GATE = WS_W;
constexpr size_t W_HG = WS_W + 38 * MiB, W_HGO = W_HG + 8 * MiB, W_UP2 = W_HGO + 2 * MiB, W_DN2 = W_UP2 + 8 * MiB, W_UP3 = W_DN2 + 8 * MiB, W_DN3 = W_UP3 + 8 * MiB, W_POOL1 = W_DN3 + 8 * MiB;
constexpr size_t WS_HB = WS_W + 81 * MiB;
constexpr size_t WS_R = WS_HB + 33 * MiB;
constexpr size_t R_HID = WS_R;
constexpr size_t R_D = WS_R;
constexpr size_t R_Q = WS_R, R_K = WS_R + 33 * MiB, R_V = R_K + 9 * MiB, R_O = R_V + 9 * MiB;
constexpr size_t R_LG = WS_R, R_HV = R_LG + 66 * MiB, R_HQ = R_HV + 33 * MiB, R_DS = R_HQ + 33 * MiB;
constexpr size_t WS_END = R_DS + 64 * MiB;
static_assert(W_POOL0 + MiB / 2 <= W_HG && WS_GATE + 33 * MiB <= W_HG && W_POOL1 + MiB / 2 <= WS_HB, "weights map");

constexpr size_t O_Y = 0, O_POOLP = (size_t)MT * DM, O_POOLS = O_POOLP + 2 * 2 * 15 * 1024, O_KP = O_POOLS + (size_t)2 * 128 * 15 * 1024,
                 O_KS = O_KP + 2 * 128 * 256, O_VP = O_KS + (size_t)128 * 128 * 256, O_VS = O_VP + 2 * 128 * 256, O_HP = O_VS + (size_t)128 * 128 * 256, O_HS = O_HP + 2 * 8 * 128 * 128;

constexpr int LDS_BYTES = 147456;

__device__ __forceinline__ float row_rinv(const float* ssq, int row) {
    const f32x4* p = (const f32x4*)(ssq + (size_t)row * 16);
    const f32x4 a = p[0], b = p[1], c = p[2], d = p[3];
    const float s = ((a.x + a.y) + (a.z + a.w)) + ((b.x + b.y) + (b.z + b.w)) + ((c.x + c.y) + (c.z + c.w)) + ((d.x + d.y) + (d.z + d.w));
    return rsqrtf(s * (1.f / 1024.f) + EPS);
}

struct EpiResid {
    static constexpr bool PERM = false, AFTER_DRAIN = false;
    const float* src_p; const float* src_s; float* h; bf16_t* hb; float* ssq; const float* cscale;
    __device__ __forceinline__ void operator()(const f32x4 (&acc)[2][2][4][2], const Unit& u, int wr, int wc, int fr, int fq) const {
        const int col0 = u.pn * 256 + wc * 32 + 4 * fq;
        f32x4 cs[2][2];
#pragma unroll
        for (int bj = 0; bj < 2; ++bj)
#pragma unroll
            for (int n = 0; n < 2; ++n) cs[bj][n] = cscale ? *(const f32x4*)(cscale + col0 + bj * 128 + n * 16) : (f32x4){1.f, 1.f, 1.f, 1.f};
#pragma unroll
        for (int ai = 0; ai < 2; ++ai)
#pragma unroll
            for (int m = 0; m < 4; ++m) {
                const int row = u.pm * 256 + ai * 128 + wr * 64 + m * 16 + fr;
                const float* sp = (row < MP ? src_p + (size_t)row * DM : src_s + (size_t)(row - MP) * DM) + col0;
                float* hp = h + (size_t)row * DM + col0; bf16_t* bp = hb + (size_t)row * DM + col0;
                float s = 0.f;
#pragma unroll
                for (int bj = 0; bj < 2; ++bj)
#pragma unroll
                    for (int n = 0; n < 2; ++n) {
                        const int off = bj * 128 + n * 16;
                        const f32x4 o = *(const f32x4*)(sp + off) + acc[ai][bj][m][n] * cs[bj][n];
                        *(f32x4*)(hp + off) = o;
                        u32x2 w; w.x = cvt_pk_bf16(o.x, o.y); w.y = cvt_pk_bf16(o.z, o.w); *(u32x2*)(bp + off) = w;
                        s += (o.x * o.x + o.y * o.y) + (o.z * o.z + o.w * o.w);
                    }
                s += __shfl_xor(s, 16); s += __shfl_xor(s, 32);
                if (fq == 0) ssq[(size_t)row * 16 + u.pn * 4 + wc] = s;
            }
    }
};
struct EpiPartial {
    static constexpr bool PERM = false, AFTER_DRAIN = false;
    float* P;
    __device__ __forceinline__ void operator()(const f32x4 (&acc)[2][2][4][2], const Unit& u, int wr, int wc, int fr, int fq) const {
        float* tp = P + (size_t)((u.ks * 8 + (u.pm - 64) * 4 + u.pn)) * 65536 + wc * 32 + 4 * fq;
#pragma unroll
        for (int ai = 0; ai < 2; ++ai)
#pragma unroll
            for (int m = 0; m < 4; ++m) {
                float* rp = tp + (ai * 128 + wr * 64 + m * 16 + fr) * 256;
#pragma unroll
                for (int bj = 0; bj < 2; ++bj)
#pragma unroll
                    for (int n = 0; n < 2; ++n) *(f32x4*)(rp + bj * 128 + n * 16) = acc[ai][bj][m][n];
            }
    }
};
struct EpiDown {
    static constexpr bool PERM = false, AFTER_DRAIN = false;
    EpiResid R; EpiPartial A;
    __device__ __forceinline__ void operator()(const f32x4 (&acc)[2][2][4][2], const Unit& u, int wr, int wc, int fr, int fq) const {
        if (u.nt) A(acc, u, wr, wc, fr, fq); else R(acc, u, wr, wc, fr, fq);
    }
};
struct EpiFfnUp {
    static constexpr bool PERM = true, AFTER_DRAIN = false;
    bf16_t* hid; const float* ssq;
    __device__ __forceinline__ void operator()(const f32x4 (&acc)[2][2][4][2], const Unit& u, int wr, int wc, int fr, int fq) const {
        const int col0 = u.pn * 256 + wc * 32 + 8 * fq;
#pragma unroll
        for (int ai = 0; ai < 2; ++ai)
#pragma unroll
            for (int m = 0; m < 4; ++m) {
                const int row = u.pm * 256 + ai * 128 + wr * 64 + m * 16 + fr;
                const float r = row_rinv(ssq, row);
                bf16_t* rp = hid + (size_t)row * FF + col0;
#pragma unroll
                for (int bj = 0; bj < 2; ++bj) {
                    f32x4 v0 = acc[ai][bj][m][0] * r, v1 = acc[ai][bj][m][1] * r;
#pragma unroll
                    for (int e = 0; e < 4; ++e) { const float a = fmaxf(v0[e], 0.f), b = fmaxf(v1[e], 0.f); v0[e] = a * a; v1[e] = b * b; }
                    u32x4 w; w.x = cvt_pk_bf16(v0[0], v0[1]); w.y = cvt_pk_bf16(v0[2], v0[3]); w.z = cvt_pk_bf16(v1[0], v1[1]); w.w = cvt_pk_bf16(v1[2], v1[3]);
                    *(u32x4*)(rp + bj * 128) = w;
                }
            }
    }
};
struct EpiQKV {
    static constexpr bool PERM = true, AFTER_DRAIN = false;
    bf16_t* Q; bf16_t* K; bf16_t* V; const float* ssq; const float* rope; float* okp; float* oks; float* ovp; float* ovs;
    __device__ __forceinline__ void operator()(const f32x4 (&acc)[2][2][4][2], const Unit& u, int wr, int wc, int fr, int fq) const {
        const int cl0 = wc * 32 + 8 * fq;
        const bool dorope = (u.pn <= 4) && ((wc & 1) == 0);
#pragma unroll
        for (int ai = 0; ai < 2; ++ai)
#pragma unroll
            for (int m = 0; m < 4; ++m) {
                const int row = u.pm * 256 + ai * 128 + wr * 64 + m * 16 + fr;
                const float r = row_rinv(ssq, row);
                const int pos = row < MP ? (row & (SEQ - 1)) : SEQ + ((row - MP) & 3);
                f32x4 cs[4];
                if (dorope) {
#pragma unroll
                    for (int e = 0; e < 4; ++e) cs[e] = *(const f32x4*)(rope + (size_t)pos * 16 + 4 * e);
                }
#pragma unroll
                for (int bj = 0; bj < 2; ++bj) {
                    f32x4 v0 = acc[ai][bj][m][0] * r, v1 = acc[ai][bj][m][1] * r;
                    if (dorope) {
                        f32x4 p0, p1;
#pragma unroll
                        for (int e = 0; e < 4; ++e) { p0[e] = __shfl_xor(v0[e], 16); p1[e] = __shfl_xor(v1[e], 16); }
                        if (fq < 2) {
                            const float sg = fq == 0 ? -1.f : 1.f;
                            v0[0] = v0[0] * cs[0][0] + sg * p0[0] * cs[0][1]; v0[1] = v0[1] * cs[0][2] + sg * p0[1] * cs[0][3];
                            v0[2] = v0[2] * cs[1][0] + sg * p0[2] * cs[1][1]; v0[3] = v0[3] * cs[1][2] + sg * p0[3] * cs[1][3];
                            v1[0] = v1[0] * cs[2][0] + sg * p1[0] * cs[2][1]; v1[1] = v1[1] * cs[2][2] + sg * p1[1] * cs[2][3];
                            v1[2] = v1[2] * cs[3][0] + sg * p1[2] * cs[3][1]; v1[3] = v1[3] * cs[3][2] + sg * p1[3] * cs[3][3];
                        }
                    }
                    u32x4 w; w.x = cvt_pk_bf16(v0[0], v0[1]); w.y = cvt_pk_bf16(v0[2], v0[3]); w.z = cvt_pk_bf16(v1[0], v1[1]); w.w = cvt_pk_bf16(v1[2], v1[3]);
                    const int cl = cl0 + bj * 128;
                    if (u.pn < 4) *(u32x4*)(Q + (size_t)row * DM + u.pn * 256 + cl) = w;
                    else {
                        bf16_t* dst = (u.pn == 4 ? K : V) + (size_t)row * 256 + cl; *(u32x4*)dst = w;
                        float* o = nullptr;
                        if (row < MP) { const int t = row & (SEQ - 1); if (t >= SEQ - 128) o = (u.pn == 4 ? okp : ovp) + ((size_t)(row >> 13) * 128 + (t - (SEQ - 128))) * 256 + cl; }
                        else { const int n = (row - MP) >> 2, i = (row - MP) & 3; o = (u.pn == 4 ? oks : ovs) + ((size_t)n * 128 + 124 + i) * 256 + cl; }
                        if (o) { *(f32x4*)o = v0; *(f32x4*)(o + 4) = v1; }
                    }
                }
            }
    }
};
struct EpiHg {
    static constexpr bool PERM = true, AFTER_DRAIN = false;
    float* LG; bf16_t* HV; bf16_t* HQ; bf16_t* GATE; const float* ssq; const float* lb;
    __device__ __forceinline__ void operator()(const f32x4 (&acc)[2][2][4][2], const Unit& u, int wr, int wc, int fr, int fq) const {
        const int type = u.pn >> 2, c0 = (u.pn & 3) * 256 + wc * 32 + 8 * fq;
        f32x4 lbv[2][2];
        if (type == 0) {
#pragma unroll
            for (int bj = 0; bj < 2; ++bj) { lbv[bj][0] = *(const f32x4*)(lb + c0 + bj * 128); lbv[bj][1] = *(const f32x4*)(lb + c0 + bj * 128 + 4); }
        }
#pragma unroll
        for (int ai = 0; ai < 2; ++ai)
#pragma unroll
            for (int m = 0; m < 4; ++m) {
                const int row = u.pm * 256 + ai * 128 + wr * 64 + m * 16 + fr;
                const float r = row_rinv(ssq, row);
#pragma unroll
                for (int bj = 0; bj < 2; ++bj) {
                    f32x4 v0 = acc[ai][bj][m][0] * r, v1 = acc[ai][bj][m][1] * r;
                    const int c = c0 + bj * 128;
                    if (type == 0) {
#pragma unroll
                        for (int e = 0; e < 4; ++e) {
                            const float s0 = 1.f / (1.f + __expf(-v0[e])), s1 = 1.f / (1.f + __expf(-v1[e]));
                            v0[e] = __logf(lbv[bj][0][e] + (1.f - lbv[bj][0][e]) * s0); v1[e] = __logf(lbv[bj][1][e] + (1.f - lbv[bj][1][e]) * s1);
                        }
                        float* o = LG + (size_t)row * DM + c; *(f32x4*)o = v0; *(f32x4*)(o + 4) = v1;
                    } else {
                        if (type >= 2) {
#pragma unroll
                            for (int e = 0; e < 4; ++e) { v0[e] = v0[e] / (1.f + __expf(-v0[e])); v1[e] = v1[e] / (1.f + __expf(-v1[e])); }
                        }
                        u32x4 w; w.x = cvt_pk_bf16(v0[0], v0[1]); w.y = cvt_pk_bf16(v0[2], v0[3]); w.z = cvt_pk_bf16(v1[0], v1[1]); w.w = cvt_pk_bf16(v1[2], v1[3]);
                        bf16_t* dst = (type == 1 ? HV : type == 2 ? HQ : GATE) + (size_t)row * DM + c;
                        *(u32x4*)dst = w;
                    }
                }
            }
    }
};

__device__ __forceinline__ void transpose_item(const float* W, int K, int N, const float* gain, bf16_t* WT, int ldk, int row_off, LAS float* scr, int item, int lane) {
    const int nblk = N / 32, kb = item / nblk, nb = item % nblk, k0 = 64 * kb, n0 = 32 * nb;
    float v[32];
#pragma unroll
    for (int i = 0; i < 32; ++i) v[i] = W[(size_t)(k0 + 2 * i + (lane >> 5)) * N + n0 + (lane & 31)];
    if (gain) {
#pragma unroll
        for (int i = 0; i < 32; ++i) v[i] *= gain[k0 + 2 * i + (lane >> 5)];
    }
#pragma unroll
    for (int i = 0; i < 32; ++i) scr[(2 * i + (lane >> 5)) * 33 + (lane & 31)] = v[i];
    asm volatile("s_waitcnt lgkmcnt(0)" ::: "memory");
    const int c = lane & 7;
#pragma unroll
    for (int j = 0; j < 4; ++j) { const int n = (lane >> 3) + 8 * j; const LAS float* s = scr + (8 * c) * 33 + n;
        u32x4 o; o.x = cvt_pk_bf16(s[0 * 33], s[1 * 33]); o.y = cvt_pk_bf16(s[2 * 33], s[3 * 33]); o.z = cvt_pk_bf16(s[4 * 33], s[5 * 33]); o.w = cvt_pk_bf16(s[6 * 33], s[7 * 33]);
        *(u32x4*)(WT + (size_t)(row_off + n0 + n) * ldk + k0 + 8 * c) = o; }
    asm volatile("s_waitcnt lgkmcnt(0)" ::: "memory");
}

struct Args { const float* in[25]; float* out; unsigned char* ws; };

template <bool SAMPLE>
__device__ __forceinline__ void pool_unit(const float* src_p, const float* src_s, const float* gmix, const float* buf, bf16_t* dbuf, float* opool, int unit, LAS float* rl, int tid, int wave, int lane) {
    const int b = unit >> 7, t0 = (unit & 127) * 64;
    const int nr = SAMPLE ? 4 : 79;
    for (int rr = wave; rr < nr; rr += 8) {
        const int t = SAMPLE ? rr : t0 - 15 + rr;
        float r = 0.f;
        if (SAMPLE || t >= 0) {
            const f32x4* xr = (const f32x4*)(SAMPLE ? src_s + (size_t)(unit * 4 + rr) * DM : src_p + (size_t)(b * SEQ + t) * DM) + lane;
            float s = 0.f;
#pragma unroll
            for (int j = 0; j < 4; ++j) { const f32x4 v = xr[64 * j]; s += (v.x * v.x + v.y * v.y) + (v.z * v.z + v.w * v.w); }
            r = rsqrtf(wave_sum(s) * (1.f / 1024.f) + EPS);
        }
        if (lane == 0) rl[rr] = r;
    }
    __syncthreads();
    const int cq = tid & 255, half = tid >> 8;
    if (!SAMPLE || half == 0) {
        const int w = 2 << (cq >> 6);
        const f32x4 g4 = *(const f32x4*)(gmix + 4 * cq);
        f32x4 ring[16];
#pragma unroll
        for (int it = 0; it < (SAMPLE ? 19 : 47); ++it) {
            f32x4 uv; int t;
            if (SAMPLE) {
                t = it - 15;
                if (it < 15) uv = *(const f32x4*)(buf + ((size_t)unit * 15 + it) * DM + 4 * cq);
                else uv = *(const f32x4*)(src_s + (size_t)(unit * 4 + t) * DM + 4 * cq) * rl[t] * g4;
            } else {
                const int rr = 32 * half + it; t = t0 - 15 + rr;
                uv = (f32x4){0.f, 0.f, 0.f, 0.f};
                if (t >= 0) uv = *(const f32x4*)(src_p + (size_t)(b * SEQ + t) * DM + 4 * cq) * rl[rr] * g4;
            }
            ring[it & 15] = uv;
            if (it >= 15) {
                const f32x4 s2 = ring[it & 15] + ring[(it - 1) & 15];
                const f32x4 s4 = s2 + (ring[(it - 2) & 15] + ring[(it - 3) & 15]);
                const f32x4 s8 = s4 + ((ring[(it - 4) & 15] + ring[(it - 5) & 15]) + (ring[(it - 6) & 15] + ring[(it - 7) & 15]));
                const f32x4 s16 = s8 + (((ring[(it - 8) & 15] + ring[(it - 9) & 15]) + (ring[(it - 10) & 15] + ring[(it - 11) & 15])) + ((ring[(it - 12) & 15] + ring[(it - 13) & 15]) + (ring[(it - 14) & 15] + ring[(it - 15) & 15])));
                const f32x4 s = w == 2 ? s2 : w == 4 ? s4 : w == 8 ? s8 : s16;
                const int cnt = SAMPLE ? w : (t + 1 < w ? t + 1 : w);
                const f32x4 d = s * (1.f / (float)cnt) - uv;
                const size_t row = SAMPLE ? (size_t)MP + unit * 4 + t : (size_t)b * SEQ + t;
                u32x2 pk; pk.x = cvt_pk_bf16(d.x, d.y); pk.y = cvt_pk_bf16(d.z, d.w);
                *(u32x2*)(dbuf + row * DM + 4 * cq) = pk;
            }
            if (SAMPLE) { if (it >= 4) *(f32x4*)(opool + ((size_t)unit * 15 + (it - 4)) * DM + 4 * cq) = uv; }
            else { if (t >= SEQ - 15) *(f32x4*)(opool + ((size_t)b * 15 + (t - (SEQ - 15))) * DM + 4 * cq) = uv; }
        }
    }
    __syncthreads();
}

__device__ __forceinline__ int crow(int r, int hi) { return (r & 3) + 8 * (r >> 2) + 4 * hi; }
__device__ __forceinline__ f32x16 attn_scores(const bf16_t* K, size_t rowbase, int q0, int j, int kvh, const bf16x8 (&qf)[4], int r32, int hi) {
    int krow = q0 - 128 + 32 * j + r32; krow = krow < 0 ? 0 : krow;
    const bf16_t* kp = K + (rowbase + krow) * 256 + kvh * 64 + hi * 8;
    f32x16 p = {};
#pragma unroll
    for (int d0 = 0; d0 < 4; ++d0) { const bf16x8 a = *(const bf16x8*)(kp + d0 * 16); p = __builtin_amdgcn_mfma_f32_32x32x16_bf16(a, qf[d0], p, 0, 0, 0); }
    MFMA_SETTLE16(p);
    const int qp = q0 + r32;
#pragma unroll
    for (int r = 0; r < 16; ++r) {
        const int kpos = q0 - 128 + 32 * j + crow(r, hi);
        const bool ok = (kpos >= 0) && (kpos <= qp) && (kpos >= qp - 128);
        p[r] = ok ? p[r] * 0.125f : -INFINITY;
    }
    return p;
}
__device__ __forceinline__ void attn_prompt_unit(const bf16_t* Q, const bf16_t* K, const bf16_t* V, bf16_t* O, const float* sinks, int unit, int wave, int lane) {
    const int kvh = unit & 3, qblk = (unit >> 2) & 127, b = unit >> 9;
    const int h = kvh * 4 + (wave & 3), q0 = qblk * 64 + 32 * (wave >> 2);
    const size_t rowbase = (size_t)b * SEQ;
    const int r32 = lane & 31, hi = lane >> 5;
    bf16x8 qf[4];
#pragma unroll
    for (int d0 = 0; d0 < 4; ++d0) qf[d0] = *(const bf16x8*)(Q + (rowbase + q0 + r32) * DM + h * 64 + d0 * 16 + hi * 8);
    const float sink = sinks[h];
    float mx = sink, l = 1.f;
#pragma unroll 1
    for (int j = 0; j < 5; ++j) {
        const f32x16 p = attn_scores(K, rowbase, q0, j, kvh, qf, r32, hi);
        float tm = p[0];
#pragma unroll
        for (int r = 1; r < 16; ++r) tm = fmaxf(tm, p[r]);
        tm = fmaxf(tm, __shfl_xor(tm, 32));
        const float mn = fmaxf(mx, tm);
        float ts = 0.f;
#pragma unroll
        for (int r = 0; r < 16; ++r) ts += __expf(p[r] - mn);
        ts += __shfl_xor(ts, 32);
        l = l * __expf(mx - mn) + ts; mx = mn;
    }
    const float inv = 1.f / l;
    f32x16 o0 = {}, o1 = {};
#pragma unroll 1
    for (int j = 0; j < 5; ++j) {
        f32x16 p = attn_scores(K, rowbase, q0, j, kvh, qf, r32, hi);
#pragma unroll
        for (int r = 0; r < 16; ++r) p[r] = __expf(p[r] - mx) * inv;
#pragma unroll
        for (int st = 0; st < 2; ++st) {
            u32x4 pw;
            pw.x = cvt_pk_bf16(p[8 * st + 0], p[8 * st + 1]); pw.y = cvt_pk_bf16(p[8 * st + 2], p[8 * st + 3]);
            pw.z = cvt_pk_bf16(p[8 * st + 4], p[8 * st + 5]); pw.w = cvt_pk_bf16(p[8 * st + 6], p[8 * st + 7]);
            const bf16x8 pa = __builtin_bit_cast(bf16x8, pw);
            bf16x8 vb0, vb1;
#pragma unroll
            for (int jj = 0; jj < 8; ++jj) {
                int krow = q0 - 128 + 32 * j + crow(8 * st + jj, hi); krow = krow < 0 ? 0 : krow;
                const bf16_t* vp = V + (rowbase + krow) * 256 + kvh * 64 + r32;
                vb0[jj] = (short)vp[0]; vb1[jj] = (short)vp[32];
            }
            o0 = __builtin_amdgcn_mfma_f32_32x32x16_bf16(pa, vb0, o0, 0, 0, 0);
            o1 = __builtin_amdgcn_mfma_f32_32x32x16_bf16(pa, vb1, o1, 0, 0, 0);
        }
    }
    MFMA_SETTLE16(o0); MFMA_SETTLE16(o1);
#pragma unroll
    for (int r = 0; r < 16; ++r) {
        bf16_t* op = O + (rowbase + q0 + crow(r, hi)) * DM + h * 64 + r32;
        op[0] = f2bf(o0[r]); op[32] = f2bf(o1[r]);
    }
}
__device__ __forceinline__ void attn_sample_wave(int n, int h, const bf16_t* Q, const bf16_t* K, const bf16_t* V, const float* ck, const float* cv, bf16_t* O, const float* sinks, LAS float* wl, int lane) {
    const int kvh = h >> 2; const size_t row0 = (size_t)MP + 4 * n;
    LAS float* wq = wl; LAS float* wp = wl + 256;
#pragma unroll
    for (int i = 0; i < 4; ++i) wq[i * 64 + lane] = bf2f(Q[(row0 + i) * DM + h * 64 + lane]);
    asm volatile("s_waitcnt lgkmcnt(0)" ::: "memory"); __builtin_amdgcn_wave_barrier();
    float sc[3][4];
#pragma unroll
    for (int kk = 0; kk < 3; ++kk) {
        float a0 = 0.f, a1 = 0.f, a2 = 0.f, a3 = 0.f;
        if (kk < 2) {
            const f32x4* kp = (const f32x4*)(ck + (((size_t)n * 128 + lane + 64 * kk) * 4 + kvh) * 64);
#pragma unroll 8
            for (int d4 = 0; d4 < 16; ++d4) { const f32x4 kv = kp[d4];
                const f32x4 q0 = *(const LAS f32x4*)(wq + 4 * d4), q1 = *(const LAS f32x4*)(wq + 64 + 4 * d4), q2 = *(const LAS f32x4*)(wq + 128 + 4 * d4), q3 = *(const LAS f32x4*)(wq + 192 + 4 * d4);
                a0 += (kv.x * q0.x + kv.y * q0.y) + (kv.z * q0.z + kv.w * q0.w); a1 += (kv.x * q1.x + kv.y * q1.y) + (kv.z * q1.z + kv.w * q1.w);
                a2 += (kv.x * q2.x + kv.y * q2.y) + (kv.z * q2.z + kv.w * q2.w); a3 += (kv.x * q3.x + kv.y * q3.y) + (kv.z * q3.z + kv.w * q3.w); }
        } else if (lane < 4) {
            const bf16_t* kp = K + (row0 + lane) * 256 + kvh * 64;
#pragma unroll 2
            for (int d = 0; d < 64; ++d) { const float kv = bf2f(kp[d]); a0 += kv * wq[d]; a1 += kv * wq[64 + d]; a2 += kv * wq[128 + d]; a3 += kv * wq[192 + d]; }
        }
        const float a[4] = {a0, a1, a2, a3};
#pragma unroll
        for (int i = 0; i < 4; ++i) {
            bool ok;
            if (kk < 2) ok = (lane + 64 * kk) >= i; else ok = (lane < 4) && (lane <= i);
            sc[kk][i] = ok ? a[i] * 0.125f : -INFINITY;
        }
    }
    const float sink = sinks[h];
#pragma unroll
    for (int i = 0; i < 4; ++i) {
        float mx = fmaxf(fmaxf(sc[0][i], sc[1][i]), sc[2][i]); mx = fmaxf(wave_max(mx), sink);
        const float e0 = __expf(sc[0][i] - mx), e1 = __expf(sc[1][i] - mx), e2 = __expf(sc[2][i] - mx);
        const float sum = wave_sum(e0 + e1 + e2) + __expf(sink - mx), inv = 1.f / sum;
        wp[i * 132 + lane] = e0 * inv; wp[i * 132 + 64 + lane] = e1 * inv; if (lane < 4) wp[i * 132 + 128 + lane] = e2 * inv;
    }
    asm volatile("s_waitcnt lgkmcnt(0)" ::: "memory"); __builtin_amdgcn_wave_barrier();
    float o[4] = {0.f, 0.f, 0.f, 0.f};
#pragma unroll 16
    for (int j = 0; j < 128; ++j) { const float v = cv[(((size_t)n * 128 + j) * 4 + kvh) * 64 + lane];
#pragma unroll
        for (int i = 0; i < 4; ++i) o[i] += wp[i * 132 + j] * v; }
#pragma unroll
    for (int jj = 0; jj < 4; ++jj) { const float v = bf2f(V[(row0 + jj) * 256 + kvh * 64 + lane]);
#pragma unroll
        for (int i = 0; i < 4; ++i) o[i] += wp[i * 132 + 128 + jj] * v; }
#pragma unroll
    for (int i = 0; i < 4; ++i) O[(row0 + i) * DM + h * 64 + lane] = f2bf(o[i]);
    asm volatile("s_waitcnt lgkmcnt(0)" ::: "memory"); __builtin_amdgcn_wave_barrier();
}

__device__ __forceinline__ f32x4 mma16(const LAS unsigned char* X, int xs, const LAS unsigned char* Y, int ys, int ksteps, f32x4 acc, int fr, int fq) {
    for (int ks = 0; ks < ksteps; ++ks) {
        const bf16x8 xv = *(const LAS bf16x8*)(X + fr * xs + ks * 64 + fq * 16);
        const bf16x8 yv = *(const LAS bf16x8*)(Y + fr * ys + ks * 64 + fq * 16);
        acc = __builtin_amdgcn_mfma_f32_16x16x32_bf16(xv, yv, acc, 0, 0, 0);
    }
    return acc;
}
constexpr int S272 = 272, S144 = 144;
constexpr int L_ST = 0, L_Q0 = 34816, L_QI = 52224, L_KT = 69632, L_A = 113152, L_VT = 122368, L_TOT = 140800, L_SSQ = 142848;
__device__ __forceinline__ void load_vt(LAS unsigned char* lds, const bf16_t* HV, size_t rowt0, int h, int tid) {
    const int s = tid >> 3, vc = (tid & 7) * 16;
    const u32x4* src = (const u32x4*)(HV + (rowt0 + s) * DM + h * 128 + vc);
    const u32x4 a = src[0], b = src[1];
    LAS unsigned short* vt = (LAS unsigned short*)(lds + L_VT);
    const unsigned w[8] = {a.x, a.y, a.z, a.w, b.x, b.y, b.z, b.w};
#pragma unroll
    for (int e = 0; e < 8; ++e) { vt[(vc + 2 * e) * 72 + s] = (unsigned short)(w[e] & 0xffffu); vt[(vc + 2 * e + 1) * 72 + s] = (unsigned short)(w[e] >> 16); }
}
__device__ __forceinline__ void hg_h1_unit(LAS unsigned char* lds, const float* LG, const bf16_t* HV, bf16_t* DS, float* Dc, int unit, int tid, int wave, int lane) {
    const int n = unit >> 10, h = (unit >> 7) & 7, c = unit & 127;
    const size_t rowt0 = (size_t)n * SEQ + c * 64;
    const int k = tid & 127, tq = tid >> 7;
    LAS float* tot = (LAS float*)(lds + L_TOT);
    float lg[16], cs[16];
    float run = 0.f;
#pragma unroll
    for (int i = 0; i < 16; ++i) { lg[i] = LG[(rowt0 + 16 * tq + i) * DM + h * 128 + k]; run += lg[i]; cs[i] = run; }
    tot[tq * 128 + k] = run;
    load_vt(lds, HV, rowt0, h, tid);
    __syncthreads();
    float base = 0.f, gend = 0.f;
#pragma unroll
    for (int q = 0; q < 4; ++q) { const float t = tot[q * 128 + k]; if (q < tq) base += t; gend += t; }
    LAS unsigned short* kt = (LAS unsigned short*)(lds + L_KT);
#pragma unroll
    for (int i = 0; i < 16; ++i) { const float kk = 1.f - __expf(lg[i]); kt[k * 72 + 16 * tq + i] = f2bf(kk * __expf(gend - (base + cs[i]))); }
    if (tq == 0) Dc[(size_t)unit * 128 + k] = __expf(gend);
    __syncthreads();
    const int fr = lane & 15, fq = lane >> 4;
#pragma unroll
    for (int vy = 0; vy < 8; ++vy) {
        f32x4 acc = {0.f, 0.f, 0.f, 0.f};
        acc = mma16(lds + L_KT + (16 * wave) * S144, S144, lds + L_VT + (16 * vy) * S144, S144, 2, acc, fr, fq);
        MFMA_SETTLE4(acc);
        u32x2 w; w.x = cvt_pk_bf16(acc[0], acc[1]); w.y = cvt_pk_bf16(acc[2], acc[3]);
        __hip_atomic_store((unsigned long long*)(DS + (size_t)unit * 16384 + (16 * vy + fr) * 128 + 16 * wave + 4 * fq), ((unsigned long long)w.y << 32) | w.x, __ATOMIC_RELAXED, __HIP_MEMORY_SCOPE_AGENT);
    }
    __syncthreads();
}
__device__ __forceinline__ void hg_h3_unit(LAS unsigned char* lds, const float* LG, const bf16_t* HV, bf16_t* HQ, const bf16_t* GATE, const bf16_t* DS, const float* gnorm, int unit, int tid, int wave, int lane) {
    const int n = unit >> 10, h = (unit >> 7) & 7, c = unit & 127;
    const size_t rowt0 = (size_t)n * SEQ + c * 64;
    const int k = tid & 127, tq = tid >> 7;
    LAS float* tot = (LAS float*)(lds + L_TOT);
    float lg[16], cs[16], qv[16];
    float run = 0.f;
#pragma unroll
    for (int i = 0; i < 16; ++i) { const size_t off = (rowt0 + 16 * tq + i) * DM + h * 128 + k; lg[i] = LG[off]; qv[i] = bf2f(HQ[off]); run += lg[i]; cs[i] = run; }
    tot[tq * 128 + k] = run;
#pragma unroll
    for (int e = 0; e < 4; ++e) { const int idx = tid + 512 * e, v = idx >> 4, ch = idx & 15;
        *(LAS u32x4*)(lds + L_ST + v * S272 + ch * 16) = *(const u32x4*)(DS + (size_t)unit * 16384 + v * 128 + ch * 8); }
    load_vt(lds, HV, rowt0, h, tid);
    __syncthreads();
    float bs[4]; { float a = 0.f;
#pragma unroll
        for (int q = 0; q < 4; ++q) { bs[q] = a; a += tot[q * 128 + k]; } }
    const float base = tq == 0 ? bs[0] : tq == 1 ? bs[1] : tq == 2 ? bs[2] : bs[3];
    LAS unsigned short* q0p = (LAS unsigned short*)(lds + L_Q0); LAS unsigned short* qip = (LAS unsigned short*)(lds + L_QI); LAS unsigned short* ktp = (LAS unsigned short*)(lds + L_KT);
#pragma unroll
    for (int i = 0; i < 16; ++i) {
        const int t = 16 * tq + i; const float G = base + cs[i];
        q0p[t * 136 + k] = f2bf(qv[i] * __expf(G));
        qip[t * 136 + k] = f2bf(qv[i] * __expf(cs[i]));
        const float kk = 1.f - __expf(lg[i]);
#pragma unroll
        for (int ii = 0; ii < 4; ++ii) if (ii >= tq) { const int rb = ii == 0 ? 0 : ii == 1 ? 16 : ii == 2 ? 48 : 96; ktp[(rb + t) * 136 + k] = f2bf(kk * __expf(bs[ii] - G)); }
    }
    __syncthreads();
    const int fr = lane & 15, fq = lane >> 4;
    for (int tl = wave; tl < 16; tl += 8) {
        int ti, tj;
        if (tl < 10) { ti = tl < 1 ? 0 : tl < 3 ? 1 : tl < 6 ? 2 : 3; tj = tl - (ti * (ti + 1)) / 2; }
        else { const int z = tl - 10; ti = z < 3 ? 0 : z < 5 ? 1 : 2; tj = z < 3 ? z + 1 : z < 5 ? z - 1 : 3; }
        f32x4 acc = {0.f, 0.f, 0.f, 0.f};
        if (tl < 10) {
            const int rb = ti == 0 ? 0 : ti == 1 ? 16 : ti == 2 ? 48 : 96;
            acc = mma16(lds + L_KT + (rb + 16 * tj) * S272, S272, lds + L_QI + (16 * ti) * S272, S272, 4, acc, fr, fq);
            MFMA_SETTLE4(acc);
            if (ti == tj) {
#pragma unroll
                for (int e = 0; e < 4; ++e) if (4 * fq + e > fr) acc[e] = 0.f;
            }
        }
        u32x2 w; w.x = cvt_pk_bf16(acc[0], acc[1]); w.y = cvt_pk_bf16(acc[2], acc[3]);
        *(LAS u32x2*)(lds + L_A + (16 * ti + fr) * S144 + (16 * tj + 4 * fq) * 2) = w;
    }
    const int tt = wave & 3, vh = wave >> 2;
    f32x4 oa[4];
#pragma unroll
    for (int vt = 0; vt < 4; ++vt) { oa[vt] = (f32x4){0.f, 0.f, 0.f, 0.f}; oa[vt] = mma16(lds + L_ST + (16 * (4 * vh + vt)) * S272, S272, lds + L_Q0 + (16 * tt) * S272, S272, 4, oa[vt], fr, fq); }
    __syncthreads();
    float ss = 0.f;
#pragma unroll
    for (int vt = 0; vt < 4; ++vt) oa[vt] = mma16(lds + L_VT + (16 * (4 * vh + vt)) * S144, S144, lds + L_A + (16 * tt) * S144, S144, 2, oa[vt], fr, fq);
    MFMA_SETTLE4(oa[0]); MFMA_SETTLE4(oa[1]); MFMA_SETTLE4(oa[2]); MFMA_SETTLE4(oa[3]);
#pragma unroll
    for (int vt = 0; vt < 4; ++vt) {
        ss += (oa[vt][0] * oa[vt][0] + oa[vt][1] * oa[vt][1]) + (oa[vt][2] * oa[vt][2] + oa[vt][3] * oa[vt][3]); }
    ss += __shfl_xor(ss, 16); ss += __shfl_xor(ss, 32);
    LAS float* sq = (LAS float*)(lds + L_SSQ);
    if (fq == 0) sq[vh * 64 + 16 * tt + fr] = ss;
    __syncthreads();
    const float rn = rsqrtf((sq[16 * tt + fr] + sq[64 + 16 * tt + fr]) * (1.f / 128.f) + EPS);
#pragma unroll
    for (int vt = 0; vt < 4; ++vt) {
        const int v = 16 * (4 * vh + vt) + 4 * fq; const size_t off = (rowt0 + 16 * tt + fr) * DM + h * 128 + v;
        const f32x4 gn = *(const f32x4*)(gnorm + h * 128 + v); const u32x2 gw = *(const u32x2*)(GATE + off);
        u32x2 w; w.x = cvt_pk_bf16(oa[vt][0] * rn * gn.x * bflo(gw.x), oa[vt][1] * rn * gn.y * bfhi(gw.x)); w.y = cvt_pk_bf16(oa[vt][2] * rn * gn.z * bflo(gw.y), oa[vt][3] * rn * gn.w * bfhi(gw.y));
        *(u32x2*)(HQ + off) = w;
    }
    __syncthreads();
}
__device__ __forceinline__ void hg_sample_unit(LAS unsigned char* lds, const float* S0, const float* LG, const bf16_t* HV, bf16_t* HQ, const bf16_t* GATE, const float* gnorm, float* Sout, int unit, int tid) {
    const int n = unit >> 3, h = unit & 7;
    const int v4 = (tid & 31) * 4, kg = tid >> 5;
    const size_t sbase = (size_t)unit * 16384;
    LAS float* red = (LAS float*)lds;
    LAS float* ol = (LAS float*)(lds + 32768);
    f32x4 S[8];
#pragma unroll
    for (int j = 0; j < 8; ++j) S[j] = *(const f32x4*)(S0 + sbase + (size_t)(8 * kg + j) * 128 + v4);
#pragma unroll 1
    for (int i = 0; i < 4; ++i) {
        const size_t roff = ((size_t)MP + 4 * n + i) * DM + h * 128;
        const u32x2 vw = *(const u32x2*)(HV + roff + v4);
        const f32x4 vv = {bflo(vw.x), bfhi(vw.x), bflo(vw.y), bfhi(vw.y)};
        f32x4 po = {0.f, 0.f, 0.f, 0.f};
#pragma unroll
        for (int j = 0; j < 8; ++j) {
            const float f = __expf(LG[roff + 8 * kg + j]), kk = 1.f - f, qq = bf2f(HQ[roff + 8 * kg + j]);
            S[j] = S[j] * f + vv * kk; po += S[j] * qq;
        }
        *(LAS f32x4*)(red + (i * 16 + kg) * 128 + v4) = po;
    }
#pragma unroll
    for (int j = 0; j < 8; ++j) *(f32x4*)(Sout + sbase + (size_t)(8 * kg + j) * 128 + v4) = S[j];
    __syncthreads();
    const int i = tid >> 7, v = tid & 127;
    float o = 0.f;
#pragma unroll
    for (int g = 0; g < 16; ++g) o += red[(i * 16 + g) * 128 + v];
    ol[i * 128 + v] = o;
    __syncthreads();
    float ss = 0.f;
    for (int e = 0; e < 128; e += 4) { const f32x4 x = *(const LAS f32x4*)(ol + i * 128 + e); ss += (x.x * x.x + x.y * x.y) + (x.z * x.z + x.w * x.w); }
    const float rn = rsqrtf(ss * (1.f / 128.f) + EPS);
    const size_t off = ((size_t)MP + 4 * n + i) * DM + h * 128 + v;
    HQ[off] = f2bf(o * rn * gnorm[h * 128 + v] * bf2f(GATE[off]));
    __syncthreads();
}


constexpr size_t WS_BAR = 1280 * 1024 + 8192;
#define XB_XCNT(j)  (256  + 64 * (j))
#define XB_XSUB(j)  (1280 + 64 * (j))
#define XB_XGEN(j)  (2304 + 64 * (j))
#define XB_TOP      3328
#define XB_TOPGEN   3392
constexpr int XB_BYTES = 16384;
struct GridBar { unsigned* bar; unsigned x, nloc, nx, G; };
__device__ __forceinline__ unsigned xb_ld(unsigned* p)              { return __hip_atomic_load(p, __ATOMIC_RELAXED, __HIP_MEMORY_SCOPE_AGENT); }
__device__ __forceinline__ unsigned xb_add(unsigned* p, unsigned v) { return __hip_atomic_fetch_add(p, v, __ATOMIC_RELAXED, __HIP_MEMORY_SCOPE_AGENT); }
__device__ __forceinline__ void grid_barrier_init(GridBar& b, unsigned* bar, unsigned G) {
    b.bar = bar; b.G = G; b.nloc = 0u; b.nx = 0u;
    b.x = (unsigned)__builtin_amdgcn_s_getreg((3 << 11) | 20) & 0xFu;
    if (threadIdx.x == 0) (void)xb_add(&bar[XB_XCNT(b.x)], 1u);
}
__device__ __forceinline__ void grid_barrier(GridBar& b) {
    asm volatile("s_waitcnt vmcnt(0)" ::: "memory");
    __syncthreads();
    if (threadIdx.x == 0) {
        unsigned* bar = b.bar;
        if (b.nloc == 0u) {
            for (;;) { unsigned sum = 0u, cnt = 0u, mine = 0u;
#pragma unroll
                for (unsigned j = 0; j < 16; ++j) { const unsigned c = xb_ld(&bar[XB_XCNT(j)]); sum += c; cnt += (c > 0u) ? 1u : 0u; mine = (j == b.x) ? c : mine; }
                if (sum == b.G) { b.nloc = mine; b.nx = cnt; break; }
                __builtin_amdgcn_s_sleep(1); }
        }
        const unsigned old = xb_add(&bar[XB_XSUB(b.x)], 1u), gen = old / b.nloc;
        if (old + 1u == (gen + 1u) * b.nloc) {
            __builtin_amdgcn_fence(__ATOMIC_RELEASE, "agent");
            asm volatile("s_waitcnt vmcnt(0)" ::: "memory");
            const unsigned og = xb_add(&bar[XB_TOP], 1u), tg = og / b.nx;
            if (og + 1u == (tg + 1u) * b.nx) (void)xb_add(&bar[XB_TOPGEN], 1u);
            else { while (xb_ld(&bar[XB_TOPGEN]) == tg) __builtin_amdgcn_s_sleep(1); }
            __builtin_amdgcn_fence(__ATOMIC_ACQUIRE, "agent");
            (void)xb_add(&bar[XB_XGEN(b.x)], 1u);
            asm volatile("s_waitcnt vmcnt(0)" ::: "memory");
        } else {
            while (xb_ld(&bar[XB_XGEN(b.x)]) == gen) __builtin_amdgcn_s_sleep(1);
            __builtin_amdgcn_fence(__ATOMIC_ACQUIRE, "agent");
            asm volatile("s_waitcnt vmcnt(0)" ::: "memory");
        }
    }
    __syncthreads();
}
#ifndef EN_POOL
#define EN_POOL 1
#define SKIP_SAMPLE 0
#ifndef USE_CG_SYNC
#define USE_CG_SYNC 0
#endif
#ifndef EXP_A
#define EXP_A 0
#endif
#ifndef SCAN_B
#define SCAN_B 16
#endif
#define NO_SCAN_STORE 0
#endif
#ifndef EN_ATT
#define EN_ATT 1
#endif
#ifndef EN_HG
#define EN_HG 1
#endif
#ifndef EN_GEMM
#define EN_GEMM 1
#endif
#ifndef EN_PRO
#define EN_PRO 1
#endif
#define IN(k) (LO <= (k) && (k) < HI)
#define PH_BEGIN const int tid = threadIdx.x; const int lane = tid & 63, wave = __builtin_amdgcn_readfirstlane(tid >> 6); (void)lane; (void)wave
#define SEAM(k) do { if (IN(k) && IN((k) + 1)) { grid_barrier(gbar); if (USE_CG_SYNC) grid.sync(); } } while (0)
#define GEMM_PHASE(EpiT, E, Aptr, Bptr, N_, K_, lda_, ldb_, acol_) do { if (!EN_GEMM) break; pg8::Gemm g{(const bf16_t*)(Aptr), (const bf16_t*)(Bptr), MT, (N_), (K_), (lda_), (ldb_), (acol_)}; \
        pg8::StaticOrder S; S.init(MT, (N_), G, bid); pg8::gemm_phase<EpiT, pg8::StaticOrder, true, true>(lds, g, S, E); } while (0)
__device__ __forceinline__ void convert_item(const Args& args, unsigned char* ws, int it, LAS float* scr, int lane) {
    const float* norm_mix = args.in[6]; const float* norm_ffn = args.in[7];
    int r = it;
#define TI(cnt, W, K, N, gain, dst, ldk, roff) if (r < (cnt)) { transpose_item((W), (K), (N), (gain), (bf16_t*)(ws + (dst)), (ldk), (roff), scr, r, lane); return; } r -= (cnt);
            TI(2048, args.in[23] + (size_t)0 * DM * FF, DM, FF, norm_ffn + 0 * DM, W_UP0, DM, 0)
            TI(2048, args.in[23] + (size_t)1 * DM * FF, DM, FF, norm_ffn + 1 * DM, W_UP1, DM, 0)
            TI(2048, args.in[23] + (size_t)2 * DM * FF, DM, FF, norm_ffn + 2 * DM, W_UP2, DM, 0)
            TI(2048, args.in[23] + (size_t)3 * DM * FF, DM, FF, norm_ffn + 3 * DM, W_UP3, DM, 0)
            TI(2048, args.in[24] + (size_t)0 * DM * FF, FF, DM, nullptr, W_DN0, FF, 0)
            TI(2048, args.in[24] + (size_t)1 * DM * FF, FF, DM, nullptr, W_DN1, FF, 0)
            TI(2048, args.in[24] + (size_t)2 * DM * FF, FF, DM, nullptr, W_DN2, FF, 0)
            TI(2048, args.in[24] + (size_t)3 * DM * FF, FF, DM, nullptr, W_DN3, FF, 0)
            TI(512, args.in[11], DM, 1024, norm_mix + 1 * DM, W_QKV, DM, 0)
            TI(128, args.in[12], DM, 256, norm_mix + 1 * DM, W_QKV, DM, 1024)
            TI(128, args.in[13], DM, 256, norm_mix + 1 * DM, W_QKV, DM, 1280)
            TI(512, args.in[14], DM, 1024, nullptr, W_SWO, DM, 0)
            TI(512, args.in[17], DM, 1024, norm_mix + 2 * DM, W_HG, DM, 0)
            TI(512, args.in[18], DM, 1024, norm_mix + 2 * DM, W_HG, DM, 1024)
            TI(512, args.in[19], DM, 1024, norm_mix + 2 * DM, W_HG, DM, 2048)
            TI(512, args.in[20], DM, 1024, norm_mix + 2 * DM, W_HG, DM, 3072)
            TI(512, args.in[21], DM, 1024, nullptr, W_HGO, DM, 0)
            { const int pi = r >> 5; r &= 31;
              transpose_item(args.in[9] + (size_t)pi * 65536, 256, 256, nullptr, (bf16_t*)(ws + (pi < 4 ? W_POOL0 : W_POOL1)), 256, (pi & 3) * 256, scr, r, lane); }
#undef TI
}
__device__ __forceinline__ int early_item(int e) { return e < 2048 ? e : e < 4096 ? 8192 + (e - 2048) : 20224 + (e - 4096); }
__device__ __forceinline__ int late_count(int layer) { return layer == 0 ? 5376 : layer == 1 ? 6656 : 4096; }
__device__ __forceinline__ int late_item(int layer, int l) {
    if (layer == 0) return l < 2048 ? 2048 + l : l < 4096 ? 10240 + (l - 2048) : 16384 + (l - 4096);
    if (layer == 1) return l < 2048 ? 4096 + l : l < 4096 ? 12288 + (l - 2048) : 17664 + (l - 4096);
    return l < 2048 ? 6144 + l : 14336 + (l - 2048);
}
#define RESID_SPLIT_GEMM(E_, APTR_, BPTR_, K_) \
            { \
                float* P = (float*)(ws + R_DS); \
                EpiDown ED{E_, EpiPartial{P}}; \
                pg8::Gemm g2{(const bf16_t*)(APTR_), (const bf16_t*)(BPTR_), MT, 1024, (K_), (K_), (K_), 0}; \
                pg8::DownOrder S2; S2.so.init(MP, 1024, 256, 0); S2.G = G; S2.c = bid; S2.S = (K_) / pg8::KSLICE; \
                if (EN_GEMM) pg8::gemm_phase<EpiDown, pg8::DownOrder, true, true>(lds, g2, S2, ED); \
                grid_barrier(gbar); \
                const int lane_ = threadIdx.x & 63, wave_ = __builtin_amdgcn_readfirstlane(threadIdx.x >> 6); \
                _Pragma("unroll 1") \
                for (int t = bid * 8 + wave_; t < MS * 4; t += G * 8) { \
                    const int r = t >> 2, qd = t & 3, row = MP + r; \
                    f32x4* xr = (f32x4*)(h + (size_t)row * DM) + qd * 64 + lane_; \
                    const float* pp = P + (size_t)((r >> 8) * 4 + qd) * 65536 + (r & 255) * 256 + 4 * lane_; \
                    f32x4 v = *xr; \
                _Pragma("unroll 8") \
                    for (int ks = 0; ks < (K_) / pg8::KSLICE; ++ks) v += *(const f32x4*)(pp + (size_t)(ks * 8) * 65536); \
                    *xr = v; \
                    u32x2 w; w.x = cvt_pk_bf16(v.x, v.y); w.y = cvt_pk_bf16(v.z, v.w); *((u32x2*)(hb + (size_t)row * DM) + qd * 64 + lane_) = w; \
                    const float sq = wave_sum((v.x * v.x + v.y * v.y) + (v.z * v.z + v.w * v.w)); \
                    if (lane_ == 0) ssq[(size_t)row * 16 + qd] = sq; \
                    else if (lane_ < 4) ssq[(size_t)row * 16 + 4 + qd * 3 + (lane_ - 1)] = 0.f; \
                } \
            }
template <int LO, int HI, int LAYER>
__device__ __forceinline__ void layer_phases(const Args& args, cg::grid_group& grid, GridBar& gbar, LAS unsigned char* lds, int G, int bid) {
    unsigned char* ws = args.ws; float* out = args.out;
    float* ssq = (float*)(ws + WS_SSQ); float* lbuf = (float*)(ws + WS_LB); float* rope = (float*)(ws + WS_ROPE); float* Dc = (float*)(ws + WS_DC);
    bf16_t* hb = (bf16_t*)(ws + WS_HB); float* h = out + O_Y;
    const float* xp = args.in[0]; const float* xs = args.in[1];
    const float* norm_mix = args.in[6];
        constexpr int layer = LAYER; constexpr int pb = layer * 7 + 1;
        constexpr int kind = layer % 3;
        const float* src_p = layer == 0 ? xp : h; const float* src_s = layer == 0 ? xs : h + (size_t)MP * DM;
        if constexpr (kind == 0) {
            constexpr int ip = layer / 3;
            if (IN(pb) && EN_POOL) {
                PH_BEGIN;
                LAS float* rl = (LAS float*)lds;
                bf16_t* dbuf = (bf16_t*)(ws + R_D);
                for (int u = bid; u < 256 + 128; u += G) {
                    if (u < 256) pool_unit<false>(src_p, src_s, norm_mix + layer * DM, nullptr, dbuf, out + O_POOLP + (size_t)ip * 2 * 15 * 1024, u, rl, tid, wave, lane);
                    else pool_unit<true>(src_p, src_s, norm_mix + layer * DM, args.in[2] + (size_t)ip * 128 * 15 * 1024, dbuf, out + O_POOLS + (size_t)ip * 128 * 15 * 1024, u - 256, rl, tid, wave, lane);
                }
            }
            SEAM(pb);
            if (IN(pb + 1)) {
                EpiResid E{src_p, src_s, h, hb, ssq, args.in[10] + ip * DM};
                GEMM_PHASE(EpiResid, E, ws + R_D, ws + (ip == 0 ? W_POOL0 : W_POOL1), 1024, 256, 1024, 256, 256);
            }
            SEAM(pb + 1);
        } else if constexpr (kind == 1) {
            if (IN(pb)) {
                EpiQKV E{(bf16_t*)(ws + R_Q), (bf16_t*)(ws + R_K), (bf16_t*)(ws + R_V), ssq, rope, out + O_KP, out + O_KS, out + O_VP, out + O_VS};
                GEMM_PHASE(EpiQKV, E, hb, ws + W_QKV, 1536, 1024, 1024, 1024, 0);
                const int extra = 396 > G ? 396 - G : 0;
                if (bid >= extra) {
                    const int gt = (bid - extra) * 512 + (int)threadIdx.x, NT = (G - extra) * 512;
                    for (int e = gt; e < 128 * 124 * 64; e += NT) { const int n = e / (124 * 64), rem = e % (124 * 64);
                        const size_t so = (size_t)n * 128 * 256 + 4 * 256 + (size_t)rem * 4, dd = (size_t)n * 128 * 256 + (size_t)rem * 4;
                        *(f32x4*)(out + O_KS + dd) = *(const f32x4*)(args.in[3] + so); *(f32x4*)(out + O_VS + dd) = *(const f32x4*)(args.in[4] + so); }
                }
            }
            SEAM(pb);
            if (IN(pb + 1) && EN_ATT) {
                PH_BEGIN;
                const bf16_t* Qb = (const bf16_t*)(ws + R_Q); const bf16_t* Kb = (const bf16_t*)(ws + R_K); const bf16_t* Vb = (const bf16_t*)(ws + R_V); bf16_t* Ob = (bf16_t*)(ws + R_O);
                for (int u = bid; u < 1024; u += G) attn_prompt_unit(Qb, Kb, Vb, Ob, args.in[15], u, wave, lane);
                for (int u = bid; u < 256; u += G) { const int wu = u * 8 + wave; attn_sample_wave(wu >> 4, wu & 15, Qb, Kb, Vb, args.in[3], args.in[4], Ob, args.in[15], (LAS float*)(lds + wave * 4096), lane); }
            }
            SEAM(pb + 1);
        } else {
            if (IN(pb)) {
                EpiHg E{(float*)(ws + R_LG), (bf16_t*)(ws + R_HV), (bf16_t*)(ws + R_HQ), (bf16_t*)(ws + WS_GATE), ssq, lbuf};
                GEMM_PHASE(EpiHg, E, hb, ws + W_HG, 4096, 1024, 1024, 1024, 0);
            }
            SEAM(pb);
            if ((IN(pb + 1) || IN(pb + 2) || IN(pb + 3)) && EN_HG) {
                const float* LG = (const float*)(ws + R_LG); const bf16_t* HV = (const bf16_t*)(ws + R_HV); bf16_t* HQ = (bf16_t*)(ws + R_HQ); const bf16_t* GATE = (const bf16_t*)(ws + WS_GATE); bf16_t* DS = (bf16_t*)(ws + R_DS);
                if (IN(pb + 1)) { PH_BEGIN; for (int u = bid; u < 2048; u += G) hg_h1_unit(lds, LG, HV, DS, Dc, u, tid, wave, lane); }
                SEAM(pb + 1);
                if (IN(pb + 2)) {
                PH_BEGIN;
                for (int gidx = bid * 512 + tid; gidx < 16 * 8192; gidx += G * 512) {
                    const int chain = gidx >> 13, e = (gidx & 8191) * 2, k = e & 127, v = e >> 7;
                    float s0 = 0.f, s1 = 0.f;
                    unsigned* dsp = (unsigned*)(DS + (size_t)chain * 128 * 16384 + e); const float* dcp = Dc + (size_t)chain * 128 * 128 + k;
                    for (int c0 = 0; c0 < 128; c0 += SCAN_B) {
                        unsigned dw[SCAN_B]; f32x2 dv[SCAN_B];
#pragma unroll
                        for (int j = 0; j < SCAN_B; ++j) { dw[j] = dsp[(size_t)(c0 + j) * 8192]; dv[j] = *(const f32x2*)(dcp + (size_t)(c0 + j) * 128); }
                        asm volatile("s_waitcnt vmcnt(0)" ::: "memory");
#pragma unroll
                        for (int j = 0; j < SCAN_B; ++j) { if (!NO_SCAN_STORE) dsp[(size_t)(c0 + j) * 8192] = cvt_pk_bf16(s0, s1); s0 = dv[j].x * s0 + bflo(dw[j]); s1 = dv[j].y * s1 + bfhi(dw[j]); }
                    }
                    float* o = out + O_HP + (size_t)chain * 16384; o[(size_t)k * 128 + v] = s0; o[(size_t)(k + 1) * 128 + v] = s1;
                }
                if (!SKIP_SAMPLE) for (int u = bid; u < 1024; u += G) hg_sample_unit(lds, args.in[5], LG, HV, HQ, GATE, args.in[22], out + O_HS, u, tid);
                }
                SEAM(pb + 2);
                if (IN(pb + 3)) { PH_BEGIN; for (int u = bid; u < 2048; u += G) hg_h3_unit(lds, LG, HV, HQ, GATE, DS, args.in[22], u, tid, wave, lane); }
                SEAM(pb + 3);
            }
        }
        if constexpr (kind != 0) {
            constexpr int ps = kind == 1 ? pb + 2 : pb + 4;
            if (IN(ps)) {
                EpiResid E{src_p, src_s, h, hb, ssq, nullptr};
                if constexpr (kind == 1) GEMM_PHASE(EpiResid, E, ws + R_O, ws + W_SWO, 1024, 1024, 1024, 1024, 0);
                else { RESID_SPLIT_GEMM(E, ws + R_HQ, ws + W_HGO, 1024); }
            }
            SEAM(ps);
        }
        const size_t wup = layer == 0 ? W_UP0 : layer == 1 ? W_UP1 : layer == 2 ? W_UP2 : W_UP3, wdn = layer == 0 ? W_DN0 : layer == 1 ? W_DN1 : layer == 2 ? W_DN2 : W_DN3;
        if (IN(pb + 5)) {
            EpiFfnUp E{(bf16_t*)(ws + R_HID), ssq};
            GEMM_PHASE(EpiFfnUp, E, hb, ws + wup, 4096, 1024, 1024, 1024, 0);
            if constexpr (layer < 3) {
                const int rem = 1056 % G;
                if (rem == 0 || bid >= rem) {
                    const int lane_ = threadIdx.x & 63, wave_ = __builtin_amdgcn_readfirstlane(threadIdx.x >> 6);
                    LAS float* scr = (LAS float*)(lds + wave_ * 16384);
                    for (int l = (bid - rem) * 8 + wave_; l < late_count(layer); l += (G - rem) * 8) convert_item(args, ws, late_item(layer, l), scr, lane_);
                }
            }
        }
        SEAM(pb + 5);
        if (IN(pb + 6) && !(EXP_A && (HI - LO) > 1)) {
            EpiResid E{h, h + (size_t)MP * DM, h, hb, ssq, nullptr};
            RESID_SPLIT_GEMM(E, ws + R_HID, ws + wdn, 4096);
        }
        SEAM(pb + 6);
    }
template <int LO, int HI>
__global__ void __launch_bounds__(512, 2) mega_fwd(Args args) {
    extern __shared__ __attribute__((aligned(16))) unsigned char lds_raw[];
    LAS unsigned char* lds = (LAS unsigned char*)lds_raw;
    cg::grid_group grid = cg::this_grid();
    const int G = gridDim.x, bid = blockIdx.x;
    GridBar gbar; grid_barrier_init(gbar, (unsigned*)(args.ws + WS_BAR), (unsigned)gridDim.x);
    if (HI - LO > 1 && gridDim.y == 0x7fffu) grid.sync();
    unsigned char* ws = args.ws; float* out = args.out;
    float* ssq = (float*)(ws + WS_SSQ); float* lbuf = (float*)(ws + WS_LB); float* rope = (float*)(ws + WS_ROPE); float* Dc = (float*)(ws + WS_DC);
    bf16_t* hb = (bf16_t*)(ws + WS_HB); float* h = out + O_Y;
    const float* xp = args.in[0]; const float* xs = args.in[1];
    const float* norm_mix = args.in[6]; const float* norm_ffn = args.in[7];

    if (IN(0) && EN_PRO) {
        PH_BEGIN;
        LAS float* scr = (LAS float*)(lds + wave * 16384);
        const int gw = bid * 8 + wave, NGW = G * 8;
        for (int e = gw; e < 4352; e += NGW) convert_item(args, ws, early_item(e), scr, lane);
        const int gt = bid * 512 + tid, NT = G * 512;
        for (int c = gt; c < 1024; c += NT) {
            const float* p = args.in[16] + c; const float a0 = p[0], a1 = p[1024], a2 = p[2048], a3 = p[3072];
            const float mx = fmaxf(fmaxf(a0, a1), fmaxf(a2, a3)); const float e0 = expf(a0 - mx), e1 = expf(a1 - mx), e2 = expf(a2 - mx), e3 = expf(a3 - mx);
            lbuf[c] = (e1 + e2) / (e0 + e1 + e2 + e3);
        }
        for (int e = gt; e < 8196 * 8; e += NT) {
            const int pos = e >> 3, j = e & 7; const float inv = powf(500000.0f, -(float)j * 0.125f); const float ang = (float)pos * inv;
            rope[(size_t)pos * 16 + 2 * j] = cosf(ang); rope[(size_t)pos * 16 + 2 * j + 1] = sinf(ang);
        }
    }
    if (IN(0) && IN(1)) __syncthreads();


    layer_phases<LO, HI, 0>(args, grid, gbar, lds, G, bid);
    layer_phases<LO, HI, 1>(args, grid, gbar, lds, G, bid);
    layer_phases<LO, HI, 2>(args, grid, gbar, lds, G, bid);
    layer_phases<LO, HI, 3>(args, grid, gbar, lds, G, bid);
    if (IN(29)) {
        PH_BEGIN;
        const float* gf = args.in[8];
        for (int row = bid * 8 + wave; row < MT; row += G * 8) {
            f32x4* xr = (f32x4*)(h + (size_t)row * DM) + lane; f32x4 v[4]; float s = 0.f;
#pragma unroll
            for (int j = 0; j < 4; ++j) { v[j] = xr[64 * j]; s += (v[j].x * v[j].x + v[j].y * v[j].y) + (v[j].z * v[j].z + v[j].w * v[j].w); }
            const float r = rsqrtf(wave_sum(s) * (1.f / 1024.f) + EPS);
#pragma unroll
            for (int j = 0; j < 4; ++j) xr[64 * j] = v[j] * r * *((const f32x4*)gf + lane + 64 * j);
        }
    }
#undef IN
#undef SEAM
#undef GEMM_PHASE
}

#define HI_LIMIT 30
#ifndef N_LAUNCH_MODE
#define MERGE_LO 0
#define MERGE_HI 22
#define PLAN(X) X(0, 30)
#define N_LAUNCH_MODE 3
#endif
template <int LO, int HI> static void launch_range(int grid, Args& a, hipStream_t stream) {
    void* kargs[] = {&a};
    hipError_t e = hipLaunchCooperativeKernel((const void*)mega_fwd<LO, HI>, dim3(grid), dim3(512), kargs, LDS_BYTES, stream);
    if (e != hipSuccess) fprintf(stderr, "cooperative launch <%d,%d> failed: %s (grid %d)\n", LO, HI, hipGetErrorString(e), grid);
}
template <int LO, int HI> static void prep_range() { (void)hipFuncSetAttribute((const void*)mega_fwd<LO, HI>, hipFuncAttributeMaxDynamicSharedMemorySize, LDS_BYTES); }
#define FOR_PHASES(X) X(0) X(1) X(2) X(6) X(7) X(8) X(9) X(10) X(13) X(14) X(15) X(16) X(17) X(18) X(19) X(20) X(21) X(22) X(23) X(27) X(28) X(29)
extern "C" void kernel_launch(void* const* d_in, const int* in_sizes, int n_in, void* d_out, int out_size, void* d_ws, size_t ws_size, hipStream_t stream) {
    static int grid = 0;
    if (grid == 0) {
        if (n_in != 25 || ws_size < WS_END) { fprintf(stderr, "kernel_launch: bad shapes: n_in %d ws %zu (need %zu)\n", n_in, ws_size, (size_t)WS_END); grid = -1; return; }
        int dev = 0, cus = 0, per_cu = 0;
        (void)hipGetDevice(&dev); (void)hipDeviceGetAttribute(&cus, hipDeviceAttributeMultiprocessorCount, dev);
#if N_LAUNCH_MODE == 1
        prep_range<0, 30>();
        (void)hipOccupancyMaxActiveBlocksPerMultiprocessor(&per_cu, (const void*)mega_fwd<0, 30>, 512, LDS_BYTES);
#elif N_LAUNCH_MODE == 3
#define PREP_R(a, b) prep_range<a, b>();
        PLAN(PREP_R)
        per_cu = 1;
#elif N_LAUNCH_MODE == 2
        prep_range<MERGE_LO, MERGE_HI>();
#define PREP(k) prep_range<k, k + 1>();
        FOR_PHASES(PREP)
        per_cu = 1;
#else
#define PREP(k) prep_range<k, k + 1>();
        FOR_PHASES(PREP)
        per_cu = 1;
#endif
        if (per_cu < 1) per_cu = 1;
        grid = cus * per_cu;
        (void)hipGetLastError();
    }
    if (grid < 0) return;
    (void)hipMemsetAsync((char*)d_ws + WS_BAR, 0, XB_BYTES, stream);
    Args a{};
    for (int i = 0; i < 25; ++i) a.in[i] = (const float*)d_in[i];
    a.out = (float*)d_out; a.ws = (unsigned char*)d_ws;
    Args& args_ = a; (void)args_;
#if N_LAUNCH_MODE == 1
    launch_range<0, 30>(grid, a, stream);
#elif N_LAUNCH_MODE == 3
#define LAUNCH_R(a, b) launch_range<a, b>(grid, args_, stream);
    PLAN(LAUNCH_R)
#elif N_LAUNCH_MODE == 2
#define LAUNCH_A(k) if ((k) < MERGE_LO) launch_range<k, k + 1>(grid, a, stream);
    FOR_PHASES(LAUNCH_A)
    launch_range<MERGE_LO, MERGE_HI>(grid, a, stream);
    if (EXP_A) launch_range<7, 8>(grid, a, stream);
#define LAUNCH_B(k) if ((k) >= MERGE_HI) launch_range<k, k + 1>(grid, a, stream);
    FOR_PHASES(LAUNCH_B)
#else
#ifndef HI_LIMIT
#define HI_LIMIT 30
#endif
#define LAUNCH(k) if ((k) < HI_LIMIT) launch_range<k, k + 1>(grid, a, stream);
    FOR_PHASES(LAUNCH)
#endif
}
```
